# Optimizing an MI355X kernel written in HIP

```python
import math
import jax, jax.numpy as jnp
from jax import lax
import numpy as np

D_MODEL = 1024
BATCH = 1
SEQ = 16384
DEPTH = 1
DEC_BATCH = 8
DEC_SEQ = 8192
PAST_LEN = 128

MIX_WIDTH = D_MODEL
ATTN_WIDTH = D_MODEL // 2
ATTN_HEAD_DIM = 64
ATTN_HEADS = ATTN_WIDTH // ATTN_HEAD_DIM
ATTN_KV_HEADS = 2
ATTN_GROUP = ATTN_HEADS // ATTN_KV_HEADS
KV_DIM = ATTN_KV_HEADS * ATTN_HEAD_DIM
WINDOW = 128
BLOCK = 128
DN_WIDTH = MIX_WIDTH - ATTN_WIDTH
DN_HEAD_DIM = 128
DN_HEADS = DN_WIDTH // DN_HEAD_DIM
CONV_WIDTH = 5
CONV_PAD = CONV_WIDTH // 2
CHUNK = 64
D_FF = 2816
ALPHA = (2.0 * DEPTH) ** 0.25
BETA_INIT = (8.0 * DEPTH) ** -0.25
LN_EPS = 1e-5
RMS_EPS = 1e-6

OFF_AK = ATTN_WIDTH
OFF_AV = OFF_AK + KV_DIM
OFF_DQ = OFF_AV + KV_DIM
OFF_DK = OFF_DQ + DN_WIDTH
OFF_DV = OFF_DK + DN_WIDTH
OFF_Z = OFF_DV + DN_WIDTH
OFF_B = OFF_Z + DN_WIDTH
OFF_A = OFF_B + 2 * DN_HEADS
PROJ_DIM = OFF_A + 2 * DN_HEADS
SPLIT_POINTS = (OFF_AK, OFF_AV, OFF_DQ, OFF_DK, OFF_DV, OFF_Z, OFF_B, OFF_A)

kernel_name = "hymba_swa_gdn_macaron_deepnorm_encoder"


def layer_norm(x, gain, bias):
    xf = x.astype(jnp.float32)
    mu = jnp.mean(xf, axis=-1, keepdims=True)
    var = jnp.mean(jnp.square(xf - mu), axis=-1, keepdims=True)
    y = (xf - mu) * lax.rsqrt(var + LN_EPS) * gain.astype(jnp.float32) + bias.astype(jnp.float32)
    return y.astype(x.dtype)


def swiglu(x, w_in, w_out):
    gate, up = jnp.split(x @ w_in, 2, axis=-1)
    return (jax.nn.silu(gate) * up) @ w_out


def l2norm(t):
    return t * lax.rsqrt(jnp.sum(t * t, axis=-1, keepdims=True) + RMS_EPS)


def windowed_gqa_attention(q, k, v, sink):
    b, l, _ = q.shape
    nb = l // BLOCK
    qb = q.reshape(b, nb, BLOCK, ATTN_KV_HEADS, ATTN_GROUP, ATTN_HEAD_DIM)

    def band(t):
        tp = jnp.pad(t, ((0, 0), (BLOCK, BLOCK), (0, 0)))
        tp = tp.reshape(b, nb + 2, BLOCK, ATTN_KV_HEADS, ATTN_HEAD_DIM)
        return jnp.concatenate([tp[:, :-2], tp[:, 1:-1], tp[:, 2:]], axis=2)

    kb, vb = band(k), band(v)
    scores = jnp.einsum('bnqhgd,bnkhd->bnhgqk', qb, kb,
                        preferred_element_type=jnp.float32) * (ATTN_HEAD_DIM ** -0.5)
    qi = jnp.arange(BLOCK)[:, None]
    kj = jnp.arange(3 * BLOCK)[None, :]
    dist = jnp.abs(qi - kj + BLOCK)
    in_win = dist <= WINDOW
    s_abs = (jnp.arange(nb)[:, None] - 1) * BLOCK + jnp.arange(3 * BLOCK)[None, :]
    in_seq = (s_abs >= 0) & (s_abs < l)
    mask = in_win[None, :, :] & in_seq[:, None, :]
    slopes = 2.0 ** (-8.0 * jnp.arange(1, ATTN_HEADS + 1, dtype=jnp.float32) / ATTN_HEADS)
    alibi = (-slopes[:, None, None] * dist.astype(jnp.float32)[None]).reshape(
        ATTN_KV_HEADS, ATTN_GROUP, BLOCK, 3 * BLOCK)
    logits = jnp.where(mask[None, :, None, None], scores + alibi[None, None], -jnp.inf)
    sink_l = sink.astype(jnp.float32).reshape(ATTN_KV_HEADS, ATTN_GROUP)[None, None, :, :, None, None]
    m = jnp.maximum(jnp.max(logits, axis=-1, keepdims=True), sink_l)
    p = jnp.exp(logits - m)
    probs = p / (jnp.sum(p, axis=-1, keepdims=True) + jnp.exp(sink_l - m))
    out = jnp.einsum('bnhgqk,bnkhd->bnqhgd', probs.astype(vb.dtype), vb)
    return out.reshape(b, l, ATTN_WIDTH)


def short_conv(x, w):
    c = x.shape[-1]
    return lax.conv_general_dilated(x, w[:, None, :], window_strides=(1,),
                                    padding=[(CONV_PAD, CONV_PAD)],
                                    dimension_numbers=('NWC', 'WIO', 'NWC'),
                                    feature_group_count=c)


def gated_delta_chunked(q, k, v, g, beta):
    b, h, l, dk = q.shape
    dv = v.shape[-1]
    nc = l // CHUNK
    q = q.reshape(b, h, nc, CHUNK, dk)
    k = k.reshape(b, h, nc, CHUNK, dk)
    v = v.reshape(b, h, nc, CHUNK, dv)
    gc = jnp.cumsum(g.reshape(b, h, nc, CHUNK), axis=-1)
    beta = beta.reshape(b, h, nc, CHUNK)
    idx = jnp.arange(CHUNK)
    incl = idx[:, None] >= idx[None, :]
    strict = idx[:, None] > idx[None, :]
    diff = gc[..., :, None] - gc[..., None, :]
    decay = jnp.where(incl, jnp.exp(jnp.where(incl, diff, 0.0)), 0.0)
    k_beta = k * beta[..., None]
    m = jnp.where(strict, jnp.einsum('bhnid,bhnjd->bhnij', k_beta, k) * decay, 0.0)
    a = m + jnp.eye(CHUNK, dtype=m.dtype)
    rhs = jnp.concatenate([v * beta[..., None], k_beta * jnp.exp(gc)[..., None]], axis=-1)
    sol = lax.linalg.triangular_solve(a, rhs, left_side=True, lower=True, unit_diagonal=True)
    u, w = sol[..., :dv], sol[..., dv:]
    attn = jnp.where(incl, jnp.einsum('bhnid,bhnjd->bhnij', q, k) * decay, 0.0)
    q_dec = q * jnp.exp(gc)[..., None]
    k_dec = k * jnp.exp(gc[..., -1:] - gc)[..., None]
    g_last = jnp.exp(gc[..., -1])

    def step(state, xs):
        q_c, k_c, u_c, w_c, attn_c, gl_c = xs
        v_new = u_c - jnp.einsum('bhcd,bhde->bhce', w_c, state)
        o_c = (jnp.einsum('bhcd,bhde->bhce', q_c, state)
               + jnp.einsum('bhij,bhje->bhie', attn_c, v_new))
        state = state * gl_c[..., None, None] + jnp.einsum('bhcd,bhce->bhde', k_c, v_new)
        return state, o_c

    xs = tuple(jnp.moveaxis(t, 2, 0) for t in (q_dec, k_dec, u, w, attn, g_last))
    s0 = jnp.zeros((b, h, dk, dv), jnp.float32)
    _, o = lax.scan(step, s0, xs)
    return jnp.moveaxis(o, 0, 2).reshape(b, h, l, dv)


def hybrid_mixer(x, w_in, conv_w, sink, a_log, dt_bias, norm_gain, w_out):
    b, l, _ = x.shape
    proj = x @ w_in
    aq, ak, av, dq, dk_, dv_, z, bb, aa = jnp.split(proj, SPLIT_POINTS, axis=-1)
    o_attn = windowed_gqa_attention(aq, ak, av, sink)
    qkv = jax.nn.silu(short_conv(jnp.concatenate([dq, dk_, dv_], axis=-1), conv_w))
    dq, dk_, dv_ = jnp.split(qkv, 3, axis=-1)

    def heads(t):
        return t.reshape(b, l, DN_HEADS, DN_HEAD_DIM).transpose(0, 2, 1, 3).astype(jnp.float32)

    q = l2norm(heads(dq)) * (DN_HEAD_DIM ** -0.5)
    k = l2norm(heads(dk_))
    v = heads(dv_)
    beta = jax.nn.sigmoid(bb.astype(jnp.float32)).reshape(b, l, 2, DN_HEADS).transpose(2, 0, 3, 1)
    a_in = aa.astype(jnp.float32).reshape(b, l, 2, DN_HEADS).transpose(2, 0, 3, 1)
    g = -jnp.exp(a_log.astype(jnp.float32))[:, None, :, None] * jax.nn.softplus(
        a_in + dt_bias.astype(jnp.float32)[:, None, :, None])
    o_fwd = gated_delta_chunked(q, k, v, g[0], beta[0])
    o_bwd = jnp.flip(gated_delta_chunked(jnp.flip(q, 2), jnp.flip(k, 2), jnp.flip(v, 2),
                                         jnp.flip(g[1], 2), jnp.flip(beta[1], 2)), 2)
    o = (o_fwd + o_bwd).transpose(0, 2, 1, 3)
    zg = z.astype(jnp.float32).reshape(b, l, DN_HEADS, DN_HEAD_DIM)
    o = (o * lax.rsqrt(jnp.mean(o * o, axis=-1, keepdims=True) + RMS_EPS)
         * norm_gain.astype(jnp.float32) * jax.nn.silu(zg))
    o_dn = o.reshape(b, l, DN_WIDTH).astype(x.dtype)
    return jnp.concatenate([o_attn, o_dn], axis=-1) @ w_out


def setup_inputs(seed: int = 0) -> dict:
    key = jax.random.key(seed)
    ks = jax.random.split(key, 16)
    f32 = jnp.float32
    x_prompt = jax.random.normal(ks[0], (BATCH, SEQ, D_MODEL), f32)
    x_sample = jax.random.normal(ks[1], (DEC_BATCH, DEC_SEQ, D_MODEL), f32)
    ffn1_w_in = jax.random.normal(ks[2], (DEPTH, D_MODEL, 2 * D_FF), f32) * (D_MODEL ** -0.5) * BETA_INIT
    ffn1_w_out = jax.random.normal(ks[3], (DEPTH, D_FF, D_MODEL), f32) * (D_FF ** -0.5) * BETA_INIT
    col_scale = jnp.concatenate([
        jnp.ones((OFF_AV,), f32), jnp.full((KV_DIM,), BETA_INIT, f32),
        jnp.ones((OFF_DV - OFF_DQ,), f32), jnp.full((DN_WIDTH,), BETA_INIT, f32),
        jnp.ones((PROJ_DIM - OFF_Z,), f32)])
    w_in = jax.random.normal(ks[4], (DEPTH, D_MODEL, PROJ_DIM), f32) * (D_MODEL ** -0.5) * col_scale
    conv_w = jax.random.normal(ks[5], (DEPTH, CONV_WIDTH, 3 * DN_WIDTH), f32) * (CONV_WIDTH ** -0.5)
    attn_sink = jax.random.normal(ks[6], (DEPTH, ATTN_HEADS), f32) * 0.5
    dn_a_log = jnp.log(jax.random.uniform(ks[7], (DEPTH, 2, DN_HEADS), f32, 1.0, 16.0))
    dt = jnp.exp(jax.random.uniform(ks[8], (DEPTH, 2, DN_HEADS), f32, math.log(1e-3), math.log(1e-1)))
    dn_dt_bias = dt + jnp.log(-jnp.expm1(-dt))
    dn_norm_gain = 1.0 + 0.02 * jax.random.normal(ks[9], (DEPTH, DN_HEAD_DIM), f32)
    w_out = jax.random.normal(ks[10], (DEPTH, MIX_WIDTH, D_MODEL), f32) * (MIX_WIDTH ** -0.5) * BETA_INIT
    ffn2_w_in = jax.random.normal(ks[11], (DEPTH, D_MODEL, 2 * D_FF), f32) * (D_MODEL ** -0.5) * BETA_INIT
    ffn2_w_out = jax.random.normal(ks[12], (DEPTH, D_FF, D_MODEL), f32) * (D_FF ** -0.5) * BETA_INIT
    ln_gain = 1.0 + 0.02 * jax.random.normal(ks[13], (DEPTH, 3, D_MODEL), f32)
    ln_bias = 0.02 * jax.random.normal(ks[14], (DEPTH, 3, D_MODEL), f32)
    return {"x_prompt": x_prompt, "x_sample": x_sample,
            "ffn1_w_in": ffn1_w_in, "ffn1_w_out": ffn1_w_out,
            "w_in": w_in, "conv_w": conv_w, "attn_sink": attn_sink,
            "dn_a_log": dn_a_log, "dn_dt_bias": dn_dt_bias, "dn_norm_gain": dn_norm_gain,
            "w_out": w_out, "ffn2_w_in": ffn2_w_in, "ffn2_w_out": ffn2_w_out,
            "ln_gain": ln_gain, "ln_bias": ln_bias}


def reference(x_prompt, x_sample, ffn1_w_in, ffn1_w_out, w_in, conv_w, attn_sink,
              dn_a_log, dn_dt_bias, dn_norm_gain, w_out, ffn2_w_in, ffn2_w_out,
              ln_gain, ln_bias):
    def trunk(x):
        for i in range(DEPTH):
            x = layer_norm(ALPHA * x + 0.5 * swiglu(x, ffn1_w_in[i], ffn1_w_out[i]),
                           ln_gain[i, 0], ln_bias[i, 0])
            x = layer_norm(ALPHA * x + hybrid_mixer(x, w_in[i], conv_w[i], attn_sink[i],
                                                   dn_a_log[i], dn_dt_bias[i],
                                                   dn_norm_gain[i], w_out[i]),
                           ln_gain[i, 1], ln_bias[i, 1])
            x = layer_norm(ALPHA * x + 0.5 * swiglu(x, ffn2_w_in[i], ffn2_w_out[i]),
                           ln_gain[i, 2], ln_bias[i, 2])
        return x

    y_prompt = trunk(x_prompt)
    y_sample = trunk(x_sample)
    return (y_prompt, y_sample)
```

```cpp
#include <hip/hip_runtime.h>
#include <hip/hip_cooperative_groups.h>
#include <cstdio>
#include <cstdint>
#include <cmath>
namespace cg = cooperative_groups;
namespace pg8 {
#define PG8_LAS __attribute__((address_space(3)))
typedef unsigned short bf16_t;
typedef short bf16x8 __attribute__((ext_vector_type(8)));
typedef float f32x4 __attribute__((ext_vector_type(4)));
typedef unsigned u32x4 __attribute__((ext_vector_type(4)));
constexpr int BM = 256, BK = 64, HALF = 128, HTB = HALF * BK * 2  , STAGE_BYTES = 8 * HTB, NXCD = 8, WGM = 8;

__host__ __device__ __forceinline__ int lds_byte(int r, int c) { const int st = (r >> 4) * 2 + (c >> 5), rr = r & 15, cc = c & 31, ob = rr * 64 + cc * 2; return st * 1024 + (ob ^ (((ob >> 9) & 1) << 5)); }
__host__ __device__ __forceinline__ void stage_rc(int b, int& R, int& C) { const int st = b / 1024, sb = b % 1024, swz = sb ^ (((sb >> 9) & 1) << 5); R = (st >> 1) * 16 + swz / 64; C = (st & 1) * 32 + (swz % 64) / 2; }
__host__ __device__ __forceinline__ int perm32(int rho) { const int n = rho >> 4, i = rho & 15; return 8 * (i >> 2) + 4 * n + (i & 3); }

struct Unit { int pm, pn; };
struct Gemm { const bf16_t* A; const bf16_t* Bt; int M, N, K; };

struct StaticOrder {
    int nM, nN, nwg, G, c;
    __host__ __device__ void init(int M, int N, int G_, int c_) { nM = M / BM; nN = N / BM; nwg = nM * nN; G = G_; c = c_; }
    __host__ __device__ bool next(int i, Unit& u) const {
        const long L = (long)i * G + c; if (L >= nwg) return false;
        int wgid = (int)L; { const int q = nwg / NXCD, r = nwg % NXCD, xcd = wgid % NXCD, off = wgid / NXCD; wgid = (xcd < r ? xcd * (q + 1) : r * (q + 1) + (xcd - r) * q) + off; }
        const int nig = WGM * nN, gid = wgid / nig, fm = gid * WGM, gsz = (nM - fm) < WGM ? (nM - fm) : WGM;
        u.pm = fm + ((wgid % nig) % gsz); u.pn = (wgid % nig) / gsz; return true;
    }
    __device__ __forceinline__ void a_ready(const Unit&) const {}
    __device__ __forceinline__ void done(const Unit&) const {}
};

__device__ __forceinline__ unsigned cvt_pk_bf16(float lo, float hi) { unsigned r; asm volatile("v_cvt_pk_bf16_f32 %0, %1, %2" : "=v"(r) : "v"(lo), "v"(hi)); return r; }
typedef float f32x2 __attribute__((ext_vector_type(2)));
typedef float f32x2 __attribute__((ext_vector_type(2)));
typedef __bf16 bf16x2v __attribute__((ext_vector_type(2)));
__device__ __forceinline__ unsigned cvtpk(float lo, float hi) { f32x2 v = {lo, hi}; bf16x2v b = __builtin_convertvector(v, bf16x2v); return __builtin_bit_cast(unsigned, b); }
__device__ __forceinline__ float silu_f(float g) { return g * __builtin_amdgcn_rcpf(1.0f + __expf(-g)); }

struct EpiSwiglu {
    static constexpr bool PERM = true, AFTER_DRAIN = false;
    bf16_t* H; int ldh;
    __device__ __forceinline__ void operator()(const f32x4 (&acc)[2][2][4][2], const Unit& u, int wr, int wc, int fr, int fq) const {
        const int row0 = u.pm * BM + wr * 64 + fr; const int col0 = u.pn * HALF + wc * 32 + 8 * fq;
#pragma unroll
        for (int ai = 0; ai < 2; ++ai)
#pragma unroll
            for (int m = 0; m < 4; ++m) {
                bf16_t* rowp = H + (size_t)(row0 + ai * HALF + m * 16) * ldh + col0;
                const f32x4 g0 = acc[ai][0][m][0], g1 = acc[ai][0][m][1], u0 = acc[ai][1][m][0], u1 = acc[ai][1][m][1];
                u32x4 w;
                w.x = cvtpk(silu_f(g0[0]) * u0[0], silu_f(g0[1]) * u0[1]); w.y = cvtpk(silu_f(g0[2]) * u0[2], silu_f(g0[3]) * u0[3]);
                w.z = cvtpk(silu_f(g1[0]) * u1[0], silu_f(g1[1]) * u1[1]); w.w = cvtpk(silu_f(g1[2]) * u1[2], silu_f(g1[3]) * u1[3]);
                *(u32x4*)rowp = w;
            }
    }
};
struct EpiResid {
    static constexpr bool PERM = false, AFTER_DRAIN = false;
    const float* base0; const float* base1; int split; float* out; float alpha, scale;
    __device__ __forceinline__ void operator()(const f32x4 (&acc)[2][2][4][2], const Unit& u, int wr, int wc, int fr, int fq) const {
        const int col0 = u.pn * BM + wc * 32 + 4 * fq;
#pragma unroll
        for (int ai = 0; ai < 2; ++ai)
#pragma unroll
            for (int m = 0; m < 4; ++m) {
                const int r = u.pm * BM + ai * HALF + wr * 64 + m * 16 + fr;
                const float* b = (r < split) ? base0 + (size_t)r * 1024 : base1 + (size_t)(r - split) * 1024;
                float* o = out + (size_t)r * 1024;
#pragma unroll
                for (int bj = 0; bj < 2; ++bj)
#pragma unroll
                    for (int n = 0; n < 2; ++n) { const int c = col0 + bj * HALF + n * 16; const f32x4 bs = *(const f32x4*)(b + c); *(f32x4*)(o + c) = bs * alpha + acc[ai][bj][m][n] * scale; }
            }
    }
};
struct EpiProj {
    static constexpr bool PERM = true, AFTER_DRAIN = false;
    bf16_t* AQKV; bf16_t* DQKV; bf16_t* Z; float* BA;
    __device__ __forceinline__ void operator()(const f32x4 (&acc)[2][2][4][2], const Unit& u, int wr, int wc, int fr, int fq) const {
        const int row0 = u.pm * BM + wr * 64 + fr; const int pn = u.pn;
        if (pn == 11) {
            if (wc == 0 && fq < 2) {
#pragma unroll
                for (int ai = 0; ai < 2; ++ai)
#pragma unroll
                    for (int m = 0; m < 4; ++m) { float* rp = BA + (size_t)(row0 + ai * HALF + m * 16) * 16 + 8 * fq; *(f32x4*)rp = acc[ai][0][m][0]; *(f32x4*)(rp + 4) = acc[ai][0][m][1]; }
            }
            return;
        }
        bf16_t* base; int ld, colt;
        if (pn < 3) { base = AQKV; ld = 768; colt = pn * BM; } else if (pn < 9) { base = DQKV; ld = 1536; colt = (pn - 3) * BM; } else { base = Z; ld = 512; colt = (pn - 9) * BM; }
        const int col0 = colt + wc * 32 + 8 * fq;
#pragma unroll
        for (int ai = 0; ai < 2; ++ai)
#pragma unroll
            for (int m = 0; m < 4; ++m) { bf16_t* rowp = base + (size_t)(row0 + ai * HALF + m * 16) * ld + col0;
#pragma unroll
                for (int bj = 0; bj < 2; ++bj) { const f32x4 v0 = acc[ai][bj][m][0], v1 = acc[ai][bj][m][1];
                    u32x4 w; w.x = cvtpk(v0[0], v0[1]); w.y = cvtpk(v0[2], v0[3]); w.z = cvtpk(v1[0], v1[1]); w.w = cvtpk(v1[2], v1[3]);
                    *(u32x4*)(rowp + bj * HALF) = w; } }
    }
};
template <class Epi, class Sched, bool ALIGN_EPI = false, bool SP2 = false>
__device__ __forceinline__ void gemm_phase(PG8_LAS unsigned char* lds, const Gemm g, const Sched& S, const Epi& E) {
    const int tid = threadIdx.x, wid = __builtin_amdgcn_readfirstlane(tid >> 6), lane = tid & 63, wr = wid >> 2, wc = wid & 3, fr = lane & 15, fq = lane >> 4;
    const int K = g.K, nt = K / BK;
    unsigned voffA[2], voffB[2];
#pragma unroll
    for (int i = 0; i < 2; ++i) { int R, C; stage_rc(tid * 16 + i * 8192, R, C); const int Rb = Epi::PERM ? ((R & ~31) + perm32(R & 31)) : R;
        voffA[i] = (unsigned)(R * K + C) * 2u; voffB[i] = (unsigned)(Rb * K + C) * 2u; }
    const size_t kstep = (size_t)(BK * 2);
    const size_t hstep = (size_t)HALF * K * 2;
    const size_t tstep = 2 * hstep;
    const unsigned ldsw = (unsigned)wid * 1024u;
    const int aoff = lds_byte(wr * 64 + fr, fq * 8), boff = lds_byte(wc * 32 + fr, fq * 8);
#define PG8_SA(b, h) (((b) * 2 + (h)) * HTB)
#define PG8_SB(b, h) ((4 + (b) * 2 + (h)) * HTB)
#define PG8_STAGE(bufoff, gbase, voff) do { _Pragma("unroll") for (int _i = 0; _i < 2; ++_i) \
        __builtin_amdgcn_global_load_lds((const unsigned*)((const char*)(gbase) + (voff)[_i]), (PG8_LAS unsigned*)(lds + (bufoff) + ldsw + _i * 8192), 16, 0, 0); } while (0)
#define PG8_LDA(dst, b, h) do { _Pragma("unroll") for (int m = 0; m < 4; ++m) _Pragma("unroll") for (int k = 0; k < 2; ++k) dst[m][k] = *(const PG8_LAS bf16x8*)(lds + PG8_SA(b, h) + aoff + m * 2048 + k * 1024); } while (0)
#define PG8_LDB(dst, b, h) do { _Pragma("unroll") for (int n = 0; n < 2; ++n) _Pragma("unroll") for (int k = 0; k < 2; ++k) dst[n][k] = *(const PG8_LAS bf16x8*)(lds + PG8_SB(b, h) + boff + n * 2048 + k * 1024); } while (0)
#define PG8_MMA(ai, bj, At, Bt) do { __builtin_amdgcn_s_setprio(1); _Pragma("unroll") for (int m = 0; m < 4; ++m) _Pragma("unroll") for (int n = 0; n < 2; ++n) _Pragma("unroll") for (int k = 0; k < 2; ++k) \
        acc[ai][bj][m][n] = __builtin_amdgcn_mfma_f32_16x16x32_bf16(Bt[n][k], At[m][k], acc[ai][bj][m][n], 0, 0, 0); __builtin_amdgcn_s_setprio(0); } while (0)
#define PG8_WAIT_V(n) asm volatile("s_waitcnt vmcnt(" #n ")" ::: "memory")
#define PG8_WAIT_L(n) asm volatile("s_waitcnt lgkmcnt(" #n ")" ::: "memory")
#define PG8_BAR __builtin_amdgcn_s_barrier()
#define PG8_SCHED __builtin_amdgcn_sched_barrier(0)
    Unit cur, nxt; int ui = 0;
    if (!S.next(0, cur)) return;
    f32x4 acc[2][2][4][2];
#pragma unroll
    for (int a = 0; a < 2; ++a)
#pragma unroll
        for (int b = 0; b < 2; ++b)
#pragma unroll
            for (int m = 0; m < 4; ++m)
#pragma unroll
                for (int n = 0; n < 2; ++n) acc[a][b][m][n] = (f32x4){0.f, 0.f, 0.f, 0.f};
    bf16x8 At[4][2], B0[2][2], B1[2][2];
    const char* cA = (const char*)g.A + (size_t)cur.pm * tstep; const char* cB = (const char*)g.Bt + (size_t)cur.pn * tstep;
    S.a_ready(cur);
    if constexpr (SP2) {
        PG8_STAGE(PG8_SB(0, 0), cB, voffB); PG8_STAGE(PG8_SB(0, 1), cB + hstep, voffB); PG8_STAGE(PG8_SA(0, 0), cA, voffA); PG8_STAGE(PG8_SA(0, 1), cA + hstep, voffA);
        if (wr == 1) PG8_BAR;
        PG8_WAIT_V(2); PG8_BAR;
        PG8_STAGE(PG8_SB(1, 0), cB + kstep, voffB); PG8_STAGE(PG8_SA(1, 0), cA + kstep, voffA); PG8_STAGE(PG8_SB(1, 1), cB + hstep + kstep, voffB);
        PG8_WAIT_V(6); PG8_BAR;
    } else {
        PG8_STAGE(PG8_SB(0, 0), cB, voffB); PG8_STAGE(PG8_SA(0, 0), cA, voffA); PG8_STAGE(PG8_SB(0, 1), cB + hstep, voffB); PG8_STAGE(PG8_SA(0, 1), cA + hstep, voffA);
        if (wr == 1) PG8_BAR;
        PG8_WAIT_V(4); PG8_BAR;
        PG8_STAGE(PG8_SB(1, 0), cB + kstep, voffB); PG8_STAGE(PG8_SA(1, 0), cA + kstep, voffA); PG8_STAGE(PG8_SB(1, 1), cB + hstep + kstep, voffB);
        PG8_WAIT_V(6); PG8_BAR;
    }
    for (;;) {
        const bool has_next = S.next(ui + 1, nxt);
        const char* nA = has_next ? (const char*)g.A + (size_t)nxt.pm * tstep : cA; const char* nB = has_next ? (const char*)g.Bt + (size_t)nxt.pn * tstep : cB;
        for (int t = 0; t < nt; t += 2) {
            const bool last = (t == nt - 2);
            const char* a1 = cA + (size_t)(t + 1) * kstep;
            const char* a2 = last ? nA : cA + (size_t)(t + 2) * kstep; const char* b2 = last ? nB : cB + (size_t)(t + 2) * kstep;
            const char* a3 = a2 + kstep; const char* b3 = b2 + kstep;
            if (last && has_next) S.a_ready(nxt);
            if constexpr (SP2) {
            PG8_LDB(B0, 0, 0); PG8_LDB(B1, 0, 1); PG8_SCHED; PG8_LDA(At, 0, 0); PG8_STAGE(PG8_SA(1, 1), a1 + hstep, voffA);
            PG8_WAIT_V(8); PG8_WAIT_L(0); PG8_BAR; PG8_MMA(0, 0, At, B0); PG8_MMA(0, 1, At, B1); PG8_BAR; PG8_SCHED;
            PG8_LDA(At, 0, 1); PG8_STAGE(PG8_SB(0, 0), b2, voffB); PG8_STAGE(PG8_SB(0, 1), b2 + hstep, voffB); PG8_STAGE(PG8_SA(0, 0), a2, voffA);
            PG8_WAIT_V(8); PG8_WAIT_L(0); PG8_BAR; PG8_MMA(1, 0, At, B0); PG8_MMA(1, 1, At, B1); PG8_BAR; PG8_SCHED;
            PG8_LDB(B0, 1, 0); PG8_LDB(B1, 1, 1); PG8_SCHED; PG8_LDA(At, 1, 0); PG8_STAGE(PG8_SA(0, 1), a2 + hstep, voffA);
            PG8_WAIT_V(8); PG8_WAIT_L(0); PG8_BAR; PG8_MMA(0, 0, At, B0); PG8_MMA(0, 1, At, B1); PG8_BAR; PG8_SCHED;
            PG8_LDA(At, 1, 1); PG8_STAGE(PG8_SB(1, 0), b3, voffB); PG8_STAGE(PG8_SB(1, 1), b3 + hstep, voffB); PG8_STAGE(PG8_SA(1, 0), a3, voffA);
            PG8_WAIT_V(8); PG8_WAIT_L(0); PG8_BAR; PG8_MMA(1, 0, At, B0); PG8_MMA(1, 1, At, B1); PG8_BAR; PG8_SCHED;
            } else {
            PG8_LDB(B0, 0, 0); PG8_SCHED; PG8_LDA(At, 0, 0); PG8_STAGE(PG8_SA(1, 1), a1 + hstep, voffA);
            PG8_WAIT_L(8); PG8_BAR; PG8_WAIT_L(0); PG8_MMA(0, 0, At, B0); PG8_BAR; PG8_SCHED;
            PG8_LDB(B1, 0, 1); PG8_STAGE(PG8_SB(0, 0), b2, voffB);
            PG8_BAR; PG8_WAIT_L(0); PG8_MMA(0, 1, At, B1); PG8_BAR;
            PG8_LDA(At, 0, 1); PG8_STAGE(PG8_SA(0, 0), a2, voffA);
            PG8_BAR; PG8_WAIT_L(0); PG8_MMA(1, 0, At, B0); PG8_BAR; PG8_SCHED;
            PG8_STAGE(PG8_SB(0, 1), b2 + hstep, voffB);
            PG8_WAIT_V(6); PG8_BAR; PG8_MMA(1, 1, At, B1); PG8_BAR;
            PG8_LDB(B0, 1, 0); PG8_SCHED; PG8_LDA(At, 1, 0); PG8_STAGE(PG8_SA(0, 1), a2 + hstep, voffA);
            PG8_WAIT_L(8); PG8_BAR; PG8_WAIT_L(0); PG8_MMA(0, 0, At, B0); PG8_BAR; PG8_SCHED;
            PG8_LDB(B1, 1, 1); PG8_STAGE(PG8_SB(1, 0), b3, voffB);
            PG8_BAR; PG8_WAIT_L(0); PG8_MMA(0, 1, At, B1); PG8_BAR;
            PG8_LDA(At, 1, 1); PG8_STAGE(PG8_SA(1, 0), a3, voffA);
            PG8_BAR; PG8_WAIT_L(0); PG8_MMA(1, 0, At, B0); PG8_BAR; PG8_SCHED;
            PG8_STAGE(PG8_SB(1, 1), b3 + hstep, voffB);
            PG8_WAIT_V(6); PG8_BAR; PG8_MMA(1, 1, At, B1); PG8_BAR;
            }
        }
        if constexpr (ALIGN_EPI) { if (wr == 0) PG8_BAR; }
        if constexpr (!Epi::AFTER_DRAIN) { E(acc, cur, wr, wc, fr, fq); S.done(cur); }
        if (!has_next) break;
#pragma unroll
        for (int a = 0; a < 2; ++a)
#pragma unroll
            for (int b = 0; b < 2; ++b)
#pragma unroll
                for (int m = 0; m < 4; ++m)
#pragma unroll
                    for (int n = 0; n < 2; ++n) acc[a][b][m][n] = (f32x4){0.f, 0.f, 0.f, 0.f};
        cur = nxt; cA = nA; cB = nB; ++ui;
        if constexpr (ALIGN_EPI) { if (wr == 1) PG8_BAR; }
    }
    PG8_WAIT_V(0);
    if constexpr (!ALIGN_EPI) { if (wr == 0) PG8_BAR; }
    PG8_BAR;
    if constexpr (Epi::AFTER_DRAIN) { E.fused(acc, cur, wr, wc, fr, fq, lds, wid, lane); S.done(cur); }
#undef PG8_SA
#undef PG8_SB
#undef PG8_STAGE
#undef PG8_LDA
#undef PG8_LDB
#undef PG8_MMA
#undef PG8_WAIT_V
#undef PG8_WAIT_L
#undef PG8_BAR
#undef PG8_SCHED
}
}

#define LAS __attribute__((address_space(3)))
typedef unsigned short bf16;
typedef short bf16x8 __attribute__((ext_vector_type(8)));
typedef float f32x4 __attribute__((ext_vector_type(4)));
typedef float f32x16 __attribute__((ext_vector_type(16)));
typedef unsigned u32x4 __attribute__((ext_vector_type(4)));
typedef unsigned u32x2 __attribute__((ext_vector_type(2)));
using pg8::cvtpk;
using pg8::silu_f;

constexpr int NT = 512;
constexpr int TT = 81920, DM = 1024, DFF = 2816, NPROJ = 3072, PROJ = 2832;
constexpr int SEQ0 = 16384, SEQS = 8192;
constexpr float ALPHA = 1.189207115002721f;
constexpr float LN_EPS = 1e-5f, RMS_EPS = 1e-6f;
constexpr float LOG2E = 1.4426950408889634f;
constexpr int LDS_BYTES = 147456;
constexpr size_t MiB = 1u << 20;
constexpr size_t WS_W1IN = 2 * MiB, WS_W1OUT = 13 * MiB, WS_WIN = 19 * MiB, WS_WOUT = 25 * MiB, WS_W2IN = 27 * MiB, WS_W2OUT = 38 * MiB;
constexpr size_t WS_XB = 44 * MiB;
constexpr size_t WS_P = 204 * MiB;
constexpr size_t WS_AQKV = 204 * MiB, WS_DQKV = 324 * MiB, WS_Z = 564 * MiB, WS_BA = 644 * MiB;
constexpr size_t WS_WF = 204 * MiB, WS_UF = 284 * MiB, WS_WB = 364 * MiB, WS_UB = 444 * MiB;
constexpr size_t WS_QN = 684 * MiB, WS_KN = 764 * MiB, WS_V2 = 844 * MiB, WS_OB = 924 * MiB, WS_GC = 1004 * MiB;
constexpr size_t WS_END = 1008 * MiB;

template <class V> __device__ __forceinline__ V lds_ld(LAS unsigned char* p, int off) { return *(LAS V*)(p + off); }
template <class V> __device__ __forceinline__ void lds_st(LAS unsigned char* p, int off, V v) { *(LAS V*)(p + off) = v; }
__device__ __forceinline__ float bf2f(unsigned short b) { return __uint_as_float((unsigned)b << 16); }
__device__ __forceinline__ float wave_sum(float v) {
#pragma unroll
    for (int o = 1; o < 64; o <<= 1) v += __shfl_xor(v, o);
    return v;
}
__device__ __forceinline__ int crow(int r, int hi) { return (r & 3) + 8 * (r >> 2) + 4 * hi; }
#define MFMA32(a, b, c) __builtin_amdgcn_mfma_f32_32x32x16_bf16((a), (b), (c), 0, 0, 0)
__device__ __forceinline__ void seq_of(int row, int& s0, int& L) { if (row < SEQ0) { s0 = 0; L = SEQ0; } else { s0 = SEQ0 + ((row - SEQ0) / SEQS) * SEQS; L = SEQS; } }

struct Params { const float* in[15]; float* out; unsigned char* ws; };

__device__ __forceinline__ void p0_transpose_item(const float* W, int K, int N, int Npad, bf16* WT, int mode, LAS float* scr, int item, int lane) {
    const int nblk = Npad / 32, kb = item / nblk, nb = item % nblk, k0 = 64 * kb, n0 = 32 * nb;
    const int nn = n0 + (lane & 31);
#pragma unroll 8
    for (int i = 0; i < 32; ++i) { const int kk = 2 * i + (lane >> 5); scr[kk * 33 + (lane & 31)] = (nn < N) ? W[(size_t)(k0 + kk) * N + nn] : 0.f; }
    asm volatile("s_waitcnt lgkmcnt(0)" ::: "memory");
    int r0 = n0;
    if (mode == 1) { const int up = n0 >= DFF ? 1 : 0; const int j0 = n0 - up * DFF; r0 = (j0 >> 7) * 256 + up * 128 + (j0 & 127); }
    const int c = lane & 7;
#pragma unroll
    for (int j = 0; j < 4; ++j) { const int n = (lane >> 3) + 8 * j; const LAS float* s = scr + (8 * c) * 33 + n;
        u32x4 o; o.x = cvtpk(s[0 * 33], s[1 * 33]); o.y = cvtpk(s[2 * 33], s[3 * 33]); o.z = cvtpk(s[4 * 33], s[5 * 33]); o.w = cvtpk(s[6 * 33], s[7 * 33]);
        *(u32x4*)(WT + (size_t)(r0 + n) * K + k0 + 8 * c) = o; }
    asm volatile("s_waitcnt lgkmcnt(0)" ::: "memory");
}
__device__ __forceinline__ void phase_p0(const Params& P, LAS unsigned char* lds, int gw, int NGW, int wave, int lane) {
    LAS float* scr = (LAS float*)(lds + wave * 16384);
    unsigned char* ws = P.ws;
    constexpr int I_1IN = (DM / 64) * (2 * DFF / 32), I_1OUT = (DFF / 64) * (DM / 32), I_IN = (DM / 64) * (NPROJ / 32), I_OUT = (DM / 64) * (DM / 32);
    constexpr int NITEMS = 2 * I_1IN + 2 * I_1OUT + I_IN + I_OUT;
    for (int it = gw; it < NITEMS; it += NGW) {
        int r = it;
        if (r < I_1IN) { p0_transpose_item(P.in[2], DM, 2 * DFF, 2 * DFF, (bf16*)(ws + WS_W1IN), 1, scr, r, lane); continue; } r -= I_1IN;
        if (r < I_1IN) { p0_transpose_item(P.in[11], DM, 2 * DFF, 2 * DFF, (bf16*)(ws + WS_W2IN), 1, scr, r, lane); continue; } r -= I_1IN;
        if (r < I_1OUT) { p0_transpose_item(P.in[3], DFF, DM, DM, (bf16*)(ws + WS_W1OUT), 0, scr, r, lane); continue; } r -= I_1OUT;
        if (r < I_1OUT) { p0_transpose_item(P.in[12], DFF, DM, DM, (bf16*)(ws + WS_W2OUT), 0, scr, r, lane); continue; } r -= I_1OUT;
        if (r < I_IN) { p0_transpose_item(P.in[4], DM, PROJ, NPROJ, (bf16*)(ws + WS_WIN), 0, scr, r, lane); continue; } r -= I_IN;
        p0_transpose_item(P.in[10], DM, DM, DM, (bf16*)(ws + WS_WOUT), 0, scr, r, lane);
    }
    bf16* XB = (bf16*)(ws + WS_XB);
    for (int m = gw; m < TT; m += NGW) {
        const float* xr = (m < SEQ0) ? P.in[0] + (size_t)m * DM : P.in[1] + (size_t)(m - SEQ0) * DM;
#pragma unroll
        for (int j = 0; j < 4; ++j) { const f32x4 v = *((const f32x4*)xr + lane + 64 * j); u32x2 o; o.x = cvtpk(v.x, v.y); o.y = cvtpk(v.z, v.w); *((u32x2*)(XB + (size_t)m * DM) + lane + 64 * j) = o; }
    }
}

__device__ __forceinline__ void phase_ln(float* io, bf16* XB, const float* gain, const float* bias, bool wr_bf, int gw, int NGW, int lane) {
    f32x4 gv[4], bv[4];
#pragma unroll
    for (int j = 0; j < 4; ++j) { gv[j] = *((const f32x4*)gain + lane + 64 * j); bv[j] = *((const f32x4*)bias + lane + 64 * j); }
    for (int m = gw; m < TT; m += NGW) {
        f32x4* xr = (f32x4*)(io + (size_t)m * DM) + lane;
        f32x4 v[4]; float s = 0.f;
#pragma unroll
        for (int j = 0; j < 4; ++j) { v[j] = xr[64 * j]; s += (v[j].x + v[j].y) + (v[j].z + v[j].w); }
        const float mean = wave_sum(s) * (1.f / DM); float s2 = 0.f;
#pragma unroll
        for (int j = 0; j < 4; ++j) { v[j] = v[j] - mean; s2 += (v[j].x * v[j].x + v[j].y * v[j].y) + (v[j].z * v[j].z + v[j].w * v[j].w); }
        const float rstd = 1.f / sqrtf(wave_sum(s2) * (1.f / DM) + LN_EPS);
#pragma unroll
        for (int j = 0; j < 4; ++j) { const f32x4 y = v[j] * rstd * gv[j] + bv[j]; xr[64 * j] = y;
            if (wr_bf) { u32x2 o; o.x = cvtpk(y.x, y.y); o.y = cvtpk(y.z, y.w); *((u32x2*)(XB + (size_t)m * DM) + lane + 64 * j) = o; } }
    }
}

constexpr int AT_KSTR = 144;
constexpr int AT_VSTR = 784;
constexpr int AT_K = 0, AT_V = 384 * AT_KSTR;
__device__ __forceinline__ void phase_attn(const bf16* AQKV, bf16* XB, const float* sink, LAS unsigned char* lds, int tid, int wave, int lane) {
    const int ql = lane & 31, hi = lane >> 5;
    for (int unit = blockIdx.x; unit < (TT / 128) * 2; unit += gridDim.x) {
        const int blk = unit >> 1, kvh = unit & 1, r0 = blk * 128;
        int s0, L; seq_of(r0, s0, L);
        __syncthreads();
        for (int c = tid; c < 384 * 8; c += NT) {
            const int kk = c >> 3, ch = c & 7, arow = r0 - 128 + kk;
            const bool valid = arow >= s0 && arow < s0 + L;
            u32x4 kv = {0u, 0u, 0u, 0u}, vv = {0u, 0u, 0u, 0u};
            if (valid) { const bf16* rp = AQKV + (size_t)arow * 768 + 64 * kvh + 8 * ch; kv = *(const u32x4*)(rp + 512); vv = *(const u32x4*)(rp + 640); }
            lds_st<u32x4>(lds, AT_K + kk * AT_KSTR + ch * 16, kv);
#pragma unroll
            for (int e = 0; e < 8; ++e) { const unsigned w = vv[e >> 1]; lds_st<unsigned short>(lds, AT_V + (8 * ch + e) * AT_VSTR + kk * 2, (unsigned short)((e & 1) ? (w >> 16) : (w & 0xffffu))); }
        }
        __syncthreads();
#pragma unroll 1
        for (int gi = 0; gi < 2; ++gi) {
            const int gq = wave * 2 + gi, hl = gq >> 2, qq = gq & 3, hq = 4 * kvh + hl;
            const int qrow = r0 + 32 * qq + ql;
            bf16x8 qf[4];
#pragma unroll
            for (int ks = 0; ks < 4; ++ks) qf[ks] = *(const bf16x8*)(AQKV + (size_t)qrow * 768 + 64 * hq + 16 * ks + 8 * hi);
            const float slope2 = exp2f(-(float)(hq + 1)) * LOG2E;
            float m = sink[hq] * LOG2E, l = 1.0f;
            f32x16 o0, o1;
#pragma unroll
            for (int r = 0; r < 16; ++r) { o0[r] = 0.f; o1[r] = 0.f; }
#pragma unroll 1
            for (int jt = qq; jt <= qq + 8; ++jt) {
                f32x16 s;
#pragma unroll
                for (int r = 0; r < 16; ++r) s[r] = 0.f;
#pragma unroll
                for (int ks = 0; ks < 4; ++ks) { const bf16x8 kf = lds_ld<bf16x8>(lds, AT_K + (32 * jt + ql) * AT_KSTR + (16 * ks + 8 * hi) * 2); s = MFMA32(kf, qf[ks], s); }
                float mx = m;
#pragma unroll
                for (int r = 0; r < 16; ++r) {
                    const int kk = 32 * jt + crow(r, hi); const int dist = 128 + 32 * qq + ql - kk; const int ad = dist < 0 ? -dist : dist; const int arow = r0 - 128 + kk;
                    const bool valid = (ad <= 128) && (arow >= s0) && (arow < s0 + L);
                    const float lg = valid ? (s[r] * (0.125f * LOG2E) - slope2 * (float)ad) : -INFINITY;
                    s[r] = lg; mx = fmaxf(mx, lg);
                }
                mx = fmaxf(mx, __shfl_xor(mx, 32));
                const float corr = exp2f(m - mx); m = mx;
                float rs = 0.f;
#pragma unroll
                for (int r = 0; r < 16; ++r) { const float p = exp2f(s[r] - mx); s[r] = p; rs += p; }
                rs += __shfl_xor(rs, 32);
                l = l * corr + rs;
#pragma unroll
                for (int r = 0; r < 16; ++r) { o0[r] *= corr; o1[r] *= corr; }
#pragma unroll
                for (int si = 0; si < 2; ++si) {
                    u32x4 pw; pw.x = cvtpk(s[8 * si + 0], s[8 * si + 1]); pw.y = cvtpk(s[8 * si + 2], s[8 * si + 3]); pw.z = cvtpk(s[8 * si + 4], s[8 * si + 5]); pw.w = cvtpk(s[8 * si + 6], s[8 * si + 7]);
                    const bf16x8 pb = __builtin_bit_cast(bf16x8, pw);
                    const int kofs = (32 * jt + 16 * si + 4 * hi) * 2;
                    { const u32x2 lo = lds_ld<u32x2>(lds, AT_V + ql * AT_VSTR + kofs), hh = lds_ld<u32x2>(lds, AT_V + ql * AT_VSTR + kofs + 16);
                      u32x4 va; va.x = lo.x; va.y = lo.y; va.z = hh.x; va.w = hh.y; o0 = MFMA32(__builtin_bit_cast(bf16x8, va), pb, o0); }
                    { const u32x2 lo = lds_ld<u32x2>(lds, AT_V + (32 + ql) * AT_VSTR + kofs), hh = lds_ld<u32x2>(lds, AT_V + (32 + ql) * AT_VSTR + kofs + 16);
                      u32x4 va; va.x = lo.x; va.y = lo.y; va.z = hh.x; va.w = hh.y; o1 = MFMA32(__builtin_bit_cast(bf16x8, va), pb, o1); }
                }
            }
            const float inv = 1.0f / l;
            bf16* orow = XB + (size_t)qrow * DM + 64 * hq + 4 * hi;
#pragma unroll
            for (int g = 0; g < 4; ++g) {
                u32x2 w0, w1;
                w0.x = cvtpk(o0[4 * g] * inv, o0[4 * g + 1] * inv); w0.y = cvtpk(o0[4 * g + 2] * inv, o0[4 * g + 3] * inv);
                w1.x = cvtpk(o1[4 * g] * inv, o1[4 * g + 1] * inv); w1.y = cvtpk(o1[4 * g + 2] * inv, o1[4 * g + 3] * inv);
                *(u32x2*)(orow + 8 * g) = w0; *(u32x2*)(orow + 32 + 8 * g) = w1;
            }
        }
    }
}

__device__ __forceinline__ void phase_conv(const bf16* DQKV, const float* convw, bf16* QN, bf16* KN, bf16* V2, int gw, int NGW, int lane) {
    for (int item = gw; item < (TT / 8) * 12; item += NGW) {
        const int tg = item / 12, ph = item - tg * 12, p = ph >> 2, h = ph & 3, t0 = tg * 8;
        int s0, L; seq_of(t0, s0, L);
        const int col = p * 512 + h * 128 + 2 * lane;
        float w0[5], w1[5];
#pragma unroll
        for (int j = 0; j < 5; ++j) { const pg8::f32x2 wv = *(const pg8::f32x2*)(convw + j * 1536 + col); w0[j] = wv.x; w1[j] = wv.y; }
        float x0[12], x1[12];
#pragma unroll
        for (int i = 0; i < 12; ++i) { const int t = t0 - 2 + i; unsigned u = 0u; if (t >= s0 && t < s0 + L) u = *(const unsigned*)(DQKV + (size_t)t * 1536 + col); x0[i] = bf2f((unsigned short)(u & 0xffffu)); x1[i] = bf2f((unsigned short)(u >> 16)); }
        bf16* dst = (p == 0) ? QN : (p == 1 ? KN : V2);
#pragma unroll
        for (int tt = 0; tt < 8; ++tt) {
            float y0 = 0.f, y1 = 0.f;
#pragma unroll
            for (int j = 0; j < 5; ++j) { y0 += w0[j] * x0[tt + j]; y1 += w1[j] * x1[tt + j]; }
            y0 = silu_f(y0); y1 = silu_f(y1);
            if (p < 2) { const float ss = wave_sum(y0 * y0 + y1 * y1); const float sc = rsqrtf(ss + RMS_EPS) * (p == 0 ? 0.08838834764831845f : 1.0f); y0 *= sc; y1 *= sc; }
            const int t = t0 + tt;
            *(unsigned*)(dst + ((size_t)(t >> 6) * 4 + h) * 8192 + (t & 63) * 128 + 2 * lane) = cvtpk(y0, y1);
        }
    }
}

constexpr int PB_QS = 0, PB_KS = 17408, PB_GK = 34816, PB_GQ = 51456, PB_KT = 68096, PB_VT = 86528, PB_MP = 104960, PB_SM = 139776;
constexpr int PB_TT = 0;
__device__ __forceinline__ void phase_prepb(const Params& P, LAS unsigned char* lds, int tid, int wave, int lane) {
    unsigned char* ws = P.ws;
    const bf16* QN = (const bf16*)(ws + WS_QN); bf16* KN = (bf16*)(ws + WS_KN); bf16* V2 = (bf16*)(ws + WS_V2);
    const float* BA = (const float*)(ws + WS_BA); float* GC = (float*)(ws + WS_GC);
    const int ql = lane & 31, hi = lane >> 5;
    for (int unit = blockIdx.x; unit < (TT / 64) * 4; unit += gridDim.x) {
        const int cidx = unit >> 2, h = unit & 3, row0 = cidx * 64;
        const size_t slot = (size_t)unit * 8192;
        __syncthreads();
#pragma unroll
        for (int i = 0; i < 2; ++i) {
            const int c = tid + i * NT, row = c >> 4, ch = c & 15;
            const u32x4 qv = *(const u32x4*)(QN + slot + row * 128 + 8 * ch), kv = *(const u32x4*)(KN + slot + row * 128 + 8 * ch), vv = *(const u32x4*)(V2 + slot + row * 128 + 8 * ch);
            lds_st<u32x4>(lds, PB_QS + row * 272 + ch * 16, qv); lds_st<u32x4>(lds, PB_KS + row * 272 + ch * 16, kv);
#pragma unroll
            for (int e = 0; e < 8; ++e) {
                const unsigned wk = kv[e >> 1], wv = vv[e >> 1];
                lds_st<unsigned short>(lds, PB_KT + (8 * ch + e) * 144 + row * 2, (unsigned short)((e & 1) ? (wk >> 16) : (wk & 0xffffu)));
                lds_st<unsigned short>(lds, PB_VT + (8 * ch + e) * 144 + row * 2, (unsigned short)((e & 1) ? (wv >> 16) : (wv & 0xffffu)));
            }
        }
        if (tid < 128) {
            const int d = tid >> 6, i = tid & 63;
            const float bval = BA[(size_t)(row0 + i) * 16 + 4 * d + h], aval = BA[(size_t)(row0 + i) * 16 + 8 + 4 * d + h];
            const float beta = 1.0f / (1.0f + __expf(-bval));
            const float xs = aval + P.in[8][4 * d + h];
            const float sp = xs > 20.f ? xs : log1pf(__expf(xs));
            float g = -__expf(P.in[7][4 * d + h]) * sp;
#pragma unroll
            for (int o = 1; o < 64; o <<= 1) { const float up = __shfl_up(g, o), dn = __shfl_down(g, o); if (d == 0) { if (i >= o) g += up; } else { if (i + o < 64) g += dn; } }
            lds_st<float>(lds, PB_SM + (d * 64 + i) * 4, beta);
            lds_st<float>(lds, PB_SM + 512 + (d * 64 + i) * 4, g);
            GC[((size_t)d * TT + row0 + i) * 4 + h] = g;
        }
        __syncthreads();
        {
            const int mat = wave >> 2, rt = (wave >> 1) & 1, ct = wave & 1;
            const int xs = mat ? PB_QS : PB_KS;
            f32x16 acc;
#pragma unroll
            for (int r = 0; r < 16; ++r) acc[r] = 0.f;
#pragma unroll
            for (int ks = 0; ks < 8; ++ks) { const bf16x8 a = lds_ld<bf16x8>(lds, xs + (32 * rt + ql) * 272 + (16 * ks + 8 * hi) * 2), b = lds_ld<bf16x8>(lds, PB_KS + (32 * ct + ql) * 272 + (16 * ks + 8 * hi) * 2); acc = MFMA32(a, b, acc); }
            const int go = mat ? PB_GQ : PB_GK;
#pragma unroll
            for (int r = 0; r < 16; ++r) lds_st<float>(lds, go + ((32 * rt + crow(r, hi)) * 65 + 32 * ct + ql) * 4, acc[r]);
        }
        __syncthreads();
        {
            const int i = tid >> 3, jb = (tid & 7) * 8;
#pragma unroll
            for (int d = 0; d < 2; ++d) {
                const float gi = lds_ld<float>(lds, PB_SM + 512 + (d * 64 + i) * 4), bi = lds_ld<float>(lds, PB_SM + (d * 64 + i) * 4);
                float av[8];
#pragma unroll
                for (int e = 0; e < 8; ++e) {
                    const int j = jb + e; const bool strict = d ? (j > i) : (j < i); const bool incl = strict || (j == i);
                    const float gj = lds_ld<float>(lds, PB_SM + 512 + (d * 64 + j) * 4);
                    const float dec = __expf(incl ? gi - gj : 0.f);
                    const float gk = lds_ld<float>(lds, PB_GK + (i * 65 + j) * 4), gq = lds_ld<float>(lds, PB_GQ + (i * 65 + j) * 4);
                    const float mv = strict ? bi * gk * dec : 0.f; av[e] = incl ? gq * dec : 0.f;
                    const int ip = d ? 63 - i : i, jp = d ? 63 - j : j;
                    lds_st<float>(lds, PB_MP + ((d * 64 + ip) * 68 + jp) * 4, mv);
                }
                u32x4 w; w.x = cvtpk(av[0], av[1]); w.y = cvtpk(av[2], av[3]); w.z = cvtpk(av[4], av[5]); w.w = cvtpk(av[6], av[7]);
                *(u32x4*)(V2 + slot + d * 4096 + i * 64 + jb) = w;
            }
        }
        __syncthreads();
        if (wave < 2) {
            const int d = wave;
            const int mb = PB_MP + d * 64 * 68 * 4;
            lds_st<float>(lds, mb + lane * 4, lane == 0 ? 1.f : 0.f);
#pragma unroll 1
            for (int i = 1; i < 64; ++i) {
                float acc = (lane == i) ? 1.f : 0.f;
                const int nq = (i + 3) >> 2;
#pragma unroll 2
                for (int kq = 0; kq < nq; ++kq) {
                    const f32x4 mv = lds_ld<f32x4>(lds, mb + (i * 68 + 4 * kq) * 4);
                    const float t0 = lds_ld<float>(lds, mb + ((4 * kq + 0) * 68 + lane) * 4), t1 = lds_ld<float>(lds, mb + ((4 * kq + 1) * 68 + lane) * 4);
                    const float t2 = lds_ld<float>(lds, mb + ((4 * kq + 2) * 68 + lane) * 4), t3 = lds_ld<float>(lds, mb + ((4 * kq + 3) * 68 + lane) * 4);
                    acc -= mv[0] * t0; acc -= mv[1] * t1; acc -= mv[2] * t2; acc -= mv[3] * t3;
                }
                asm volatile("s_waitcnt lgkmcnt(0)" ::: "memory");
                lds_st<float>(lds, mb + (i * 68 + lane) * 4, acc);
            }
            asm volatile("s_waitcnt lgkmcnt(0)" ::: "memory");
            const int k = d ? 63 - lane : lane;
            const float su = lds_ld<float>(lds, PB_SM + (d * 64 + k) * 4);
            const float sw = su * __expf(lds_ld<float>(lds, PB_SM + 512 + (d * 64 + k) * 4));
#pragma unroll 4
            for (int ip = 0; ip < 64; ++ip) {
                const int i = d ? 63 - ip : ip;
                const float tv = lds_ld<float>(lds, mb + (ip * 68 + lane) * 4);
                const unsigned pk = cvtpk(tv * su, tv * sw);
                lds_st<unsigned short>(lds, PB_TT + (2 * d) * 9216 + i * 144 + k * 2, (unsigned short)(pk & 0xffffu));
                lds_st<unsigned short>(lds, PB_TT + (2 * d + 1) * 9216 + i * 144 + k * 2, (unsigned short)(pk >> 16));
            }
        }
        __syncthreads();
        {
            const int d = wave >> 2, pt = (wave >> 1) & 1, rt = wave & 1;
            bf16x8 tf[4];
#pragma unroll
            for (int ks = 0; ks < 4; ++ks) tf[ks] = lds_ld<bf16x8>(lds, PB_TT + (2 * d + pt) * 9216 + (32 * rt + ql) * 144 + (16 * ks + 8 * hi) * 2);
            bf16* dstb = (bf16*)(ws + (pt == 0 ? (d ? WS_UB : WS_UF) : (d ? WS_WB : WS_WF))) + slot;
            const int xo = pt == 0 ? PB_VT : PB_KT;
#pragma unroll 1
            for (int ct = 0; ct < 4; ++ct) {
                f32x16 acc;
#pragma unroll
                for (int r = 0; r < 16; ++r) acc[r] = 0.f;
#pragma unroll
                for (int ks = 0; ks < 4; ++ks) { const bf16x8 xf = lds_ld<bf16x8>(lds, xo + (32 * ct + ql) * 144 + (16 * ks + 8 * hi) * 2); acc = (pt == 0) ? MFMA32(tf[ks], xf, acc) : MFMA32(xf, tf[ks], acc); }
#pragma unroll
                for (int g = 0; g < 4; ++g) {
                    u32x2 w; w.x = cvtpk(acc[4 * g], acc[4 * g + 1]); w.y = cvtpk(acc[4 * g + 2], acc[4 * g + 3]);
                    if (pt == 0) *(u32x2*)(dstb + (32 * ct + ql) * 64 + 32 * rt + 8 * g + 4 * hi) = w;
                    else *(u32x2*)(dstb + (32 * rt + ql) * 128 + 32 * ct + 8 * g + 4 * hi) = w;
                }
            }
#pragma unroll
            for (int i = 0; i < 2; ++i) { const int c = tid + i * NT, dk = c >> 3, ch = c & 7; *(u32x4*)(KN + slot + dk * 64 + 8 * ch) = lds_ld<u32x4>(lds, PB_KT + dk * 144 + ch * 16); }
        }
    }
}

constexpr int SC_W = 0, SC_Q = 16384, SC_KT = 32768, SC_A = 49152, SC_UT = 57344, SC_GC = 61440, SC_BUF = 61696;
constexpr int SC_ST = 2 * SC_BUF, SC_V1 = SC_ST + 8192, SC_V2 = SC_V1 + 4096;
__device__ __forceinline__ int sw256(int row, int ch) { return row * 256 + ((ch ^ (row & 15)) << 4); }
__device__ __forceinline__ int sw128(int row, int ch) { return row * 128 + ((ch ^ (row & 7)) << 4); }
struct ScanRegs { u32x4 w[2], q[2], kt[2], a, ut; float gc; };
__device__ __forceinline__ void scan_load(ScanRegs& R, const unsigned char* ws, int cidx, int h, int d, int e, int tid) {
    const size_t slot = ((size_t)cidx * 4 + h) * 8192;
    const bf16* Wp = (const bf16*)(ws + (d ? WS_WB : WS_WF)) + slot; const bf16* Qp = (const bf16*)(ws + WS_QN) + slot; const bf16* Kp = (const bf16*)(ws + WS_KN) + slot;
    const bf16* Ap = (const bf16*)(ws + WS_V2) + slot + d * 4096; const bf16* Up = (const bf16*)(ws + (d ? WS_UB : WS_UF)) + slot + (32 * e) * 64;
#pragma unroll
    for (int i = 0; i < 2; ++i) { const int c = tid + i * NT; R.w[i] = *(const u32x4*)(Wp + c * 8); R.q[i] = *(const u32x4*)(Qp + c * 8); R.kt[i] = *(const u32x4*)(Kp + c * 8); }
    R.a = *(const u32x4*)(Ap + tid * 8);
    if (tid < 256) R.ut = *(const u32x4*)(Up + tid * 8);
    if (tid < 64) R.gc = ((const float*)(ws + WS_GC))[((size_t)d * TT + (size_t)cidx * 64 + tid) * 4 + h];
}
__device__ __forceinline__ void scan_store(const ScanRegs& R, LAS unsigned char* lds, int buf, int tid) {
    const int b = buf * SC_BUF;
#pragma unroll
    for (int i = 0; i < 2; ++i) { const int c = tid + i * NT;
        lds_st<u32x4>(lds, b + SC_W + sw256(c >> 4, c & 15), R.w[i]); lds_st<u32x4>(lds, b + SC_Q + sw256(c >> 4, c & 15), R.q[i]); lds_st<u32x4>(lds, b + SC_KT + sw128(c >> 3, c & 7), R.kt[i]); }
    lds_st<u32x4>(lds, b + SC_A + sw128(tid >> 3, tid & 7), R.a);
    if (tid < 256) lds_st<u32x4>(lds, b + SC_UT + sw128(tid >> 3, tid & 7), R.ut);
    if (tid < 64) lds_st<float>(lds, b + SC_GC + tid * 4, R.gc);
}
__device__ __forceinline__ void phase_scan(const Params& P, LAS unsigned char* lds, int tid, int wave, int lane) {
    unsigned char* ws = P.ws;
    bf16* XB = (bf16*)(ws + WS_XB); bf16* OB = (bf16*)(ws + WS_OB);
    const int ql = lane & 31, hi = lane >> 5;
    for (int it = blockIdx.x; it < 288; it += gridDim.x) {
        int seq, rem;
        if (it < 224) { seq = 1 + (it >> 5); rem = it & 31; } else if (it < 256) { seq = 0; rem = it - 224; } else { const int sc = it - 32; seq = 1 + (sc >> 5); rem = sc & 31; }
        const int h = rem >> 3, d = (rem >> 2) & 1, e = rem & 3;
        const int s0 = seq == 0 ? 0 : SEQ0 + (seq - 1) * SEQS, L = seq == 0 ? SEQ0 : SEQS, nc = L / 64, c0 = s0 / 64;
        __syncthreads();
        f32x16 S;
#pragma unroll
        for (int r = 0; r < 16; ++r) S[r] = 0.f;
        for (int i = tid; i < 8192 / 16; i += NT) lds_st<u32x4>(lds, SC_ST + i * 16, (u32x4){0u, 0u, 0u, 0u});
        ScanRegs R;
        scan_load(R, ws, c0 + (d ? nc - 1 : 0), h, d, e, tid);
        scan_store(R, lds, 0, tid);
        __syncthreads();
#pragma unroll 1
        for (int t = 0; t < nc; ++t) {
            const int cidx = c0 + (d ? nc - 1 - t : t), row0 = cidx * 64;
            const int b = (t & 1) * SC_BUF;
            if (t + 1 < nc) scan_load(R, ws, c0 + (d ? nc - 2 - t : t + 1), h, d, e, tid);
            const float gcl = lds_ld<float>(lds, b + SC_GC + (d ? 0 : 63) * 4);
            f32x16 acc;
#pragma unroll
            for (int r = 0; r < 16; ++r) acc[r] = 0.f;
            const int rt = wave & 1;
            if (wave < 4) {
                const int ao = b + (wave < 2 ? SC_W : SC_Q);
#pragma unroll
                for (int ks = 0; ks < 8; ++ks) { const bf16x8 a = lds_ld<bf16x8>(lds, ao + sw256(32 * rt + ql, 2 * ks + hi)), bb = lds_ld<bf16x8>(lds, SC_ST + sw256(ql, 2 * ks + hi)); acc = MFMA32(a, bb, acc); }
            }
            if (wave < 2) {
#pragma unroll
                for (int g = 0; g < 4; ++g) {
                    const int tk = 32 * rt + 8 * g + 4 * hi;
                    const u32x2 uu = lds_ld<u32x2>(lds, b + SC_UT + sw128(ql, tk >> 3) + (tk & 7) * 2);
                    const f32x4 gcv = lds_ld<f32x4>(lds, b + SC_GC + tk * 4);
                    const float v0 = bf2f((unsigned short)(uu.x & 0xffffu)) - acc[4 * g], v1 = bf2f((unsigned short)(uu.x >> 16)) - acc[4 * g + 1];
                    const float v2 = bf2f((unsigned short)(uu.y & 0xffffu)) - acc[4 * g + 2], v3 = bf2f((unsigned short)(uu.y >> 16)) - acc[4 * g + 3];
                    u32x2 w1, w2; w1.x = cvtpk(v0, v1); w1.y = cvtpk(v2, v3);
                    w2.x = cvtpk(v0 * __expf(gcl - gcv[0]), v1 * __expf(gcl - gcv[1])); w2.y = cvtpk(v2 * __expf(gcl - gcv[2]), v3 * __expf(gcl - gcv[3]));
                    lds_st<u32x2>(lds, SC_V1 + sw128(ql, tk >> 3) + (tk & 7) * 2, w1); lds_st<u32x2>(lds, SC_V2 + sw128(ql, tk >> 3) + (tk & 7) * 2, w2);
                }
            }
            __syncthreads();
            if (wave == 2 || wave == 3) {
#pragma unroll
                for (int g = 0; g < 4; ++g) { const int tk = 32 * rt + 8 * g + 4 * hi; const f32x4 gcv = lds_ld<f32x4>(lds, b + SC_GC + tk * 4);
#pragma unroll
                    for (int x = 0; x < 4; ++x) acc[4 * g + x] *= __expf(gcv[x]); }
#pragma unroll
                for (int ks = 0; ks < 4; ++ks) { const bf16x8 a = lds_ld<bf16x8>(lds, b + SC_A + sw128(32 * rt + ql, 2 * ks + hi)), bb = lds_ld<bf16x8>(lds, SC_V1 + sw128(ql, 2 * ks + hi)); acc = MFMA32(a, bb, acc); }
                bf16* op = d ? OB + (size_t)row0 * 512 + 128 * h + 32 * e + ql : XB + (size_t)row0 * DM + 512 + 128 * h + 32 * e + ql;
                const int ost = d ? 512 : DM;
#pragma unroll
                for (int r = 0; r < 16; ++r) op[(size_t)(32 * rt + crow(r, hi)) * ost] = (bf16)(cvtpk(acc[r], 0.f) & 0xffffu);
            } else if (wave >= 4) {
                const int dkt = wave - 4; const float gl = __expf(gcl);
#pragma unroll
                for (int r = 0; r < 16; ++r) S[r] *= gl;
#pragma unroll
                for (int ks = 0; ks < 4; ++ks) { const bf16x8 a = lds_ld<bf16x8>(lds, b + SC_KT + sw128(32 * dkt + ql, 2 * ks + hi)), bb = lds_ld<bf16x8>(lds, SC_V2 + sw128(ql, 2 * ks + hi)); S = MFMA32(a, bb, S); }
#pragma unroll
                for (int g = 0; g < 4; ++g) { u32x2 w; w.x = cvtpk(S[4 * g], S[4 * g + 1]); w.y = cvtpk(S[4 * g + 2], S[4 * g + 3]); const int dk = 32 * dkt + 8 * g + 4 * hi; lds_st<u32x2>(lds, SC_ST + sw256(ql, dk >> 3) + (dk & 7) * 2, w); }
            }
            if (t + 1 < nc) scan_store(R, lds, (t + 1) & 1, tid);
            __syncthreads();
        }
    }
}

__device__ __forceinline__ void phase_gate(const Params& P, int gw, int NGW, int lane) {
    unsigned char* ws = P.ws;
    bf16* XB = (bf16*)(ws + WS_XB); const bf16* OB = (const bf16*)(ws + WS_OB); const bf16* Z = (const bf16*)(ws + WS_Z);
    float gn[8];
#pragma unroll
    for (int x = 0; x < 8; ++x) gn[x] = P.in[9][8 * (lane & 15) + x];
    for (int m = gw; m < TT; m += NGW) {
        bf16* xp = XB + (size_t)m * DM + 512 + 8 * lane;
        const u32x4 a = *(const u32x4*)xp, b = *(const u32x4*)(OB + (size_t)m * 512 + 8 * lane), z = *(const u32x4*)(Z + (size_t)m * 512 + 8 * lane);
        float o[8]; float ss = 0.f;
#pragma unroll
        for (int x = 0; x < 4; ++x) { o[2 * x] = bf2f((unsigned short)(a[x] & 0xffffu)) + bf2f((unsigned short)(b[x] & 0xffffu)); o[2 * x + 1] = bf2f((unsigned short)(a[x] >> 16)) + bf2f((unsigned short)(b[x] >> 16)); ss += o[2 * x] * o[2 * x] + o[2 * x + 1] * o[2 * x + 1]; }
        ss += __shfl_xor(ss, 1); ss += __shfl_xor(ss, 2); ss += __shfl_xor(ss, 4); ss += __shfl_xor(ss, 8);
        const float rs = rsqrtf(ss * (1.0f / 128.0f) + RMS_EPS);
        u32x4 w;
#pragma unroll
        for (int x = 0; x < 4; ++x) { const float z0 = bf2f((unsigned short)(z[x] & 0xffffu)), z1 = bf2f((unsigned short)(z[x] >> 16)); w[x] = cvtpk(o[2 * x] * rs * gn[2 * x] * silu_f(z0), o[2 * x + 1] * rs * gn[2 * x + 1] * silu_f(z1)); }
        *(u32x4*)xp = w;
    }
}

__global__ void __launch_bounds__(NT, 2) fwd_megakernel(Params P) {
    extern __shared__ __attribute__((aligned(16))) unsigned char lds_raw[];
    LAS unsigned char* lds = (LAS unsigned char*)lds_raw;
    cg::grid_group grid = cg::this_grid();
    const int tid = threadIdx.x, lane = tid & 63, wave = __builtin_amdgcn_readfirstlane(tid >> 6);
    const int G = gridDim.x, gw = blockIdx.x * 8 + wave, NGW = G * 8;
    unsigned char* ws = P.ws;
    bf16* XB = (bf16*)(ws + WS_XB); bf16* H = (bf16*)(ws + WS_P);
    float* out = P.out;

#ifndef SKIP_P0
    phase_p0(P, lds, gw, NGW, wave, lane);
#endif
    grid.sync();
    { pg8::Gemm g{XB, (const bf16*)(ws + WS_W1IN), TT, 2 * DFF, DM}; pg8::StaticOrder S; S.init(TT, 2 * DFF, G, (int)blockIdx.x);
      pg8::EpiSwiglu E{H, DFF}; pg8::gemm_phase<pg8::EpiSwiglu, pg8::StaticOrder, true, true>(lds, g, S, E); }
    grid.sync();
    { pg8::Gemm g{H, (const bf16*)(ws + WS_W1OUT), TT, DM, DFF}; pg8::StaticOrder S; S.init(TT, DM, G, (int)blockIdx.x);
      pg8::EpiResid E{P.in[0], P.in[1], SEQ0, out, ALPHA, 0.5f}; pg8::gemm_phase<pg8::EpiResid, pg8::StaticOrder, true, true>(lds, g, S, E); }
    grid.sync();
    phase_ln(out, XB, P.in[13], P.in[14], true, gw, NGW, lane);
    grid.sync();
    { pg8::Gemm g{XB, (const bf16*)(ws + WS_WIN), TT, NPROJ, DM}; pg8::StaticOrder S; S.init(TT, NPROJ, G, (int)blockIdx.x);
      pg8::EpiProj E{(bf16*)(ws + WS_AQKV), (bf16*)(ws + WS_DQKV), (bf16*)(ws + WS_Z), (float*)(ws + WS_BA)}; pg8::gemm_phase<pg8::EpiProj, pg8::StaticOrder, true, true>(lds, g, S, E); }
    grid.sync();
#ifndef SKIP_ATTN
    phase_attn((const bf16*)(ws + WS_AQKV), XB, P.in[6], lds, tid, wave, lane);
#endif
#ifndef SKIP_CONV
    phase_conv((const bf16*)(ws + WS_DQKV), P.in[5], (bf16*)(ws + WS_QN), (bf16*)(ws + WS_KN), (bf16*)(ws + WS_V2), gw, NGW, lane);
#endif
    grid.sync();
#ifndef SKIP_PREPB
    phase_prepb(P, lds, tid, wave, lane);
#endif
    grid.sync();
#ifndef SKIP_SCAN
    phase_scan(P, lds, tid, wave, lane);
#endif
    grid.sync();
#ifndef SKIP_GATE
    phase_gate(P, gw, NGW, lane);
#endif
    grid.sync();
    { pg8::Gemm g{XB, (const bf16*)(ws + WS_WOUT), TT, DM, DM}; pg8::StaticOrder S; S.init(TT, DM, G, (int)blockIdx.x);
      pg8::EpiResid E{out, out, TT, out, ALPHA, 1.0f}; pg8::gemm_phase<pg8::EpiResid, pg8::StaticOrder, true, true>(lds, g, S, E); }
    grid.sync();
    phase_ln(out, XB, P.in[13] + DM, P.in[14] + DM, true, gw, NGW, lane);
    grid.sync();
    { pg8::Gemm g{XB, (const bf16*)(ws + WS_W2IN), TT, 2 * DFF, DM}; pg8::StaticOrder S; S.init(TT, 2 * DFF, G, (int)blockIdx.x);
      pg8::EpiSwiglu E{H, DFF}; pg8::gemm_phase<pg8::EpiSwiglu, pg8::StaticOrder, true, true>(lds, g, S, E); }
    grid.sync();
    { pg8::Gemm g{H, (const bf16*)(ws + WS_W2OUT), TT, DM, DFF}; pg8::StaticOrder S; S.init(TT, DM, G, (int)blockIdx.x);
      pg8::EpiResid E{out, out, TT, out, ALPHA, 0.5f}; pg8::gemm_phase<pg8::EpiResid, pg8::StaticOrder, true, true>(lds, g, S, E); }
    grid.sync();
    phase_ln(out, XB, P.in[13] + 2 * DM, P.in[14] + 2 * DM, false, gw, NGW, lane);
}

extern "C" void kernel_launch(void* const* d_in, const int* in_sizes, int n_in, void* d_out, int out_size, void* d_ws, size_t ws_size, hipStream_t stream) {
    static int grid = 0;
    if (grid == 0) {
        if (n_in != 15 || out_size != TT * DM || ws_size < WS_END) { fprintf(stderr, "kernel_launch: unexpected shapes (n_in %d, out %d, ws %zu)\n", n_in, out_size, ws_size); grid = -1; return; }
        int dev = 0, cus = 0, per_cu = 0;
        hipGetDevice(&dev); hipDeviceGetAttribute(&cus, hipDeviceAttributeMultiprocessorCount, dev);
        if (hipFuncSetAttribute((const void*)fwd_megakernel, hipFuncAttributeMaxDynamicSharedMemorySize, LDS_BYTES) != hipSuccess) { fprintf(stderr, "kernel_launch: hipFuncSetAttribute failed\n"); grid = -1; return; }
        if (hipOccupancyMaxActiveBlocksPerMultiprocessor(&per_cu, (const void*)fwd_megakernel, NT, LDS_BYTES) != hipSuccess || per_cu < 1) { fprintf(stderr, "kernel_launch: occupancy query says %d\n", per_cu); per_cu = 1; }
        (void)hipGetLastError();
        grid = cus;
    }
    if (grid < 0) return;
    Params p{};
    for (int i = 0; i < 15; ++i) p.in[i] = (const float*)d_in[i];
    p.out = (float*)d_out; p.ws = (unsigned char*)d_ws;
    void* args[] = {&p};
    hipError_t e = hipLaunchCooperativeKernel((const void*)fwd_megakernel, dim3(grid), dim3(NT), args, LDS_BYTES, stream);
    if (e != hipSuccess) fprintf(stderr, "cooperative launch failed: %s (grid %d)\n", hipGetErrorString(e), grid);
}
```

```cpp
#include <hip/hip_runtime.h>
#include <hip/hip_cooperative_groups.h>
#include <cstdio>
#include <cstdint>
#include <cmath>
namespace cg = cooperative_groups;
namespace pg8 {
#define PG8_LAS __attribute__((address_space(3)))
typedef unsigned short bf16_t;
typedef short bf16x8 __attribute__((ext_vector_type(8)));
typedef float f32x4 __attribute__((ext_vector_type(4)));
typedef unsigned u32x4 __attribute__((ext_vector_type(4)));
constexpr int BM = 256, BK = 64, HALF = 128, HTB = HALF * BK * 2  , STAGE_BYTES = 8 * HTB, NXCD = 8, WGM = 8;

__host__ __device__ __forceinline__ int lds_byte(int r, int c) { const int st = (r >> 4) * 2 + (c >> 5), rr = r & 15, cc = c & 31, ob = rr * 64 + cc * 2; return st * 1024 + (ob ^ (((ob >> 9) & 1) << 5)); }
__host__ __device__ __forceinline__ void stage_rc(int b, int& R, int& C) { const int st = b / 1024, sb = b % 1024, swz = sb ^ (((sb >> 9) & 1) << 5); R = (st >> 1) * 16 + swz / 64; C = (st & 1) * 32 + (swz % 64) / 2; }
__host__ __device__ __forceinline__ int perm32(int rho) { const int n = rho >> 4, i = rho & 15; return 8 * (i >> 2) + 4 * n + (i & 3); }

struct Unit { int pm, pn; };
struct Gemm { const bf16_t* A; const bf16_t* Bt; int M, N, K; };

struct StaticOrder {
    int nM, nN, nwg, G, c;
    __host__ __device__ void init(int M, int N, int G_, int c_) { nM = M / BM; nN = N / BM; nwg = nM * nN; G = G_; c = c_; }
    __host__ __device__ bool next(int i, Unit& u) const {
        const long L = (long)i * G + c; if (L >= nwg) return false;
        int wgid = (int)L; { const int q = nwg / NXCD, r = nwg % NXCD, xcd = wgid % NXCD, off = wgid / NXCD; wgid = (xcd < r ? xcd * (q + 1) : r * (q + 1) + (xcd - r) * q) + off; }
        const int nig = WGM * nN, gid = wgid / nig, fm = gid * WGM, gsz = (nM - fm) < WGM ? (nM - fm) : WGM;
        u.pm = fm + ((wgid % nig) % gsz); u.pn = (wgid % nig) / gsz; return true;
    }
    __device__ __forceinline__ void a_ready(const Unit&) const {}
    __device__ __forceinline__ void done(const Unit&) const {}
};

__device__ __forceinline__ unsigned cvt_pk_bf16(float lo, float hi) { unsigned r; asm volatile("v_cvt_pk_bf16_f32 %0, %1, %2" : "=v"(r) : "v"(lo), "v"(hi)); return r; }
typedef float f32x2 __attribute__((ext_vector_type(2)));
typedef float f32x2 __attribute__((ext_vector_type(2)));
typedef __bf16 bf16x2v __attribute__((ext_vector_type(2)));
__device__ __forceinline__ unsigned cvtpk(float lo, float hi) { f32x2 v = {lo, hi}; bf16x2v b = __builtin_convertvector(v, bf16x2v); return __builtin_bit_cast(unsigned, b); }
__device__ __forceinline__ float silu_f(float g) { return g * __builtin_amdgcn_rcpf(1.0f + __expf(-g)); }

struct EpiSwiglu {
    static constexpr bool PERM = true, AFTER_DRAIN = false;
    bf16_t* H; int ldh;
    __device__ __forceinline__ void operator()(const f32x4 (&acc)[2][2][4][2], const Unit& u, int wr, int wc, int fr, int fq) const {
        const int row0 = u.pm * BM + wr * 64 + fr; const int col0 = u.pn * HALF + wc * 32 + 8 * fq;
#pragma unroll
        for (int ai = 0; ai < 2; ++ai)
#pragma unroll
            for (int m = 0; m < 4; ++m) {
                bf16_t* rowp = H + (size_t)(row0 + ai * HALF + m * 16) * ldh + col0;
                const f32x4 g0 = acc[ai][0][m][0], g1 = acc[ai][0][m][1], u0 = acc[ai][1][m][0], u1 = acc[ai][1][m][1];
                u32x4 w;
                w.x = cvtpk(silu_f(g0[0]) * u0[0], silu_f(g0[1]) * u0[1]); w.y = cvtpk(silu_f(g0[2]) * u0[2], silu_f(g0[3]) * u0[3]);
                w.z = cvtpk(silu_f(g1[0]) * u1[0], silu_f(g1[1]) * u1[1]); w.w = cvtpk(silu_f(g1[2]) * u1[2], silu_f(g1[3]) * u1[3]);
                *(u32x4*)rowp = w;
            }
    }
};
struct EpiResid {
    static constexpr bool PERM = false, AFTER_DRAIN = false;
    const float* base0; const float* base1; int split; float* out; float alpha, scale;
    __device__ __forceinline__ void operator()(const f32x4 (&acc)[2][2][4][2], const Unit& u, int wr, int wc, int fr, int fq) const {
        const int col0 = u.pn * BM + wc * 32 + 4 * fq;
#pragma unroll
        for (int ai = 0; ai < 2; ++ai)
#pragma unroll
            for (int m = 0; m < 4; ++m) {
                const int r = u.pm * BM + ai * HALF + wr * 64 + m * 16 + fr;
                const float* b = (r < split) ? base0 + (size_t)r * 1024 : base1 + (size_t)(r - split) * 1024;
                float* o = out + (size_t)r * 1024;
#pragma unroll
                for (int bj = 0; bj < 2; ++bj)
#pragma unroll
                    for (int n = 0; n < 2; ++n) { const int c = col0 + bj * HALF + n * 16; const f32x4 bs = *(const f32x4*)(b + c); *(f32x4*)(o + c) = bs * alpha + acc[ai][bj][m][n] * scale; }
            }
    }
};
struct EpiProj {
    static constexpr bool PERM = true, AFTER_DRAIN = false;
    bf16_t* AQKV; bf16_t* DQKV; bf16_t* Z; float* BA;
    __device__ __forceinline__ void operator()(const f32x4 (&acc)[2][2][4][2], const Unit& u, int wr, int wc, int fr, int fq) const {
        const int row0 = u.pm * BM + wr * 64 + fr; const int pn = u.pn;
        if (pn == 11) {
            if (wc == 0 && fq < 2) {
#pragma unroll
                for (int ai = 0; ai < 2; ++ai)
#pragma unroll
                    for (int m = 0; m < 4; ++m) { float* rp = BA + (size_t)(row0 + ai * HALF + m * 16) * 16 + 8 * fq; *(f32x4*)rp = acc[ai][0][m][0]; *(f32x4*)(rp + 4) = acc[ai][0][m][1]; }
            }
            return;
        }
        bf16_t* base; int ld, colt;
        if (pn < 3) { base = AQKV; ld = 768; colt = pn * BM; } else if (pn < 9) { base = DQKV; ld = 1536; colt = (pn - 3) * BM; } else { base = Z; ld = 512; colt = (pn - 9) * BM; }
        const int col0 = colt + wc * 32 + 8 * fq;
#pragma unroll
        for (int ai = 0; ai < 2; ++ai)
#pragma unroll
            for (int m = 0; m < 4; ++m) { bf16_t* rowp = base + (size_t)(row0 + ai * HALF + m * 16) * ld + col0;
#pragma unroll
                for (int bj = 0; bj < 2; ++bj) { const f32x4 v0 = acc[ai][bj][m][0], v1 = acc[ai][bj][m][1];
                    u32x4 w; w.x = cvtpk(v0[0], v0[1]); w.y = cvtpk(v0[2], v0[3]); w.z = cvtpk(v1[0], v1[1]); w.w = cvtpk(v1[2], v1[3]);
                    *(u32x4*)(rowp + bj * HALF) = w; } }
    }
};
template <class Epi, class Sched, bool ALIGN_EPI = false, bool SP2 = false>
__device__ __forceinline__ void gemm_phase(PG8_LAS unsigned char* lds, const Gemm g, const Sched& S, const Epi& E) {
    const int tid = threadIdx.x, wid = __builtin_amdgcn_readfirstlane(tid >> 6), lane = tid & 63, wr = wid >> 2, wc = wid & 3, fr = lane & 15, fq = lane >> 4;
    const int K = g.K, nt = K / BK;
    unsigned voffA[2], voffB[2];
#pragma unroll
    for (int i = 0; i < 2; ++i) { int R, C; stage_rc(tid * 16 + i * 8192, R, C); const int Rb = Epi::PERM ? ((R & ~31) + perm32(R & 31)) : R;
        voffA[i] = (unsigned)(R * K + C) * 2u; voffB[i] = (unsigned)(Rb * K + C) * 2u; }
    const size_t kstep = (size_t)(BK * 2);
    const size_t hstep = (size_t)HALF * K * 2;
    const size_t tstep = 2 * hstep;
    const unsigned ldsw = (unsigned)wid * 1024u;
    const int aoff = lds_byte(wr * 64 + fr, fq * 8), boff = lds_byte(wc * 32 + fr, fq * 8);
#define PG8_SA(b, h) (((b) * 2 + (h)) * HTB)
#define PG8_SB(b, h) ((4 + (b) * 2 + (h)) * HTB)
#define PG8_STAGE(bufoff, gbase, voff) do { _Pragma("unroll") for (int _i = 0; _i < 2; ++_i) \
        __builtin_amdgcn_global_load_lds((const unsigned*)((const char*)(gbase) + (voff)[_i]), (PG8_LAS unsigned*)(lds + (bufoff) + ldsw + _i * 8192), 16, 0, 0); } while (0)
#define PG8_LDA(dst, b, h) do { _Pragma("unroll") for (int m = 0; m < 4; ++m) _Pragma("unroll") for (int k = 0; k < 2; ++k) dst[m][k] = *(const PG8_LAS bf16x8*)(lds + PG8_SA(b, h) + aoff + m * 2048 + k * 1024); } while (0)
#define PG8_LDB(dst, b, h) do { _Pragma("unroll") for (int n = 0; n < 2; ++n) _Pragma("unroll") for (int k = 0; k < 2; ++k) dst[n][k] = *(const PG8_LAS bf16x8*)(lds + PG8_SB(b, h) + boff + n * 2048 + k * 1024); } while (0)
#define PG8_MMA(ai, bj, At, Bt) do { __builtin_amdgcn_s_setprio(1); _Pragma("unroll") for (int m = 0; m < 4; ++m) _Pragma("unroll") for (int n = 0; n < 2; ++n) _Pragma("unroll") for (int k = 0; k < 2; ++k) \
        acc[ai][bj][m][n] = __builtin_amdgcn_mfma_f32_16x16x32_bf16(Bt[n][k], At[m][k], acc[ai][bj][m][n], 0, 0, 0); __builtin_amdgcn_s_setprio(0); } while (0)
#define PG8_WAIT_V(n) asm volatile("s_waitcnt vmcnt(" #n ")" ::: "memory")
#define PG8_WAIT_L(n) asm volatile("s_waitcnt lgkmcnt(" #n ")" ::: "memory")
#define PG8_BAR __builtin_amdgcn_s_barrier()
#define PG8_SCHED __builtin_amdgcn_sched_barrier(0)
    Unit cur, nxt; int ui = 0;
    if (!S.next(0, cur)) return;
    f32x4 acc[2][2][4][2];
#pragma unroll
    for (int a = 0; a < 2; ++a)
#pragma unroll
        for (int b = 0; b < 2; ++b)
#pragma unroll
            for (int m = 0; m < 4; ++m)
#pragma unroll
                for (int n = 0; n < 2; ++n) acc[a][b][m][n] = (f32x4){0.f, 0.f, 0.f, 0.f};
    bf16x8 At[4][2], B0[2][2], B1[2][2];
    const char* cA = (const char*)g.A + (size_t)cur.pm * tstep; const char* cB = (const char*)g.Bt + (size_t)cur.pn * tstep;
    S.a_ready(cur);
    if constexpr (SP2) {
        PG8_STAGE(PG8_SB(0, 0), cB, voffB); PG8_STAGE(PG8_SB(0, 1), cB + hstep, voffB); PG8_STAGE(PG8_SA(0, 0), cA, voffA); PG8_STAGE(PG8_SA(0, 1), cA + hstep, voffA);
        if (wr == 1) PG8_BAR;
        PG8_WAIT_V(2); PG8_BAR;
        PG8_STAGE(PG8_SB(1, 0), cB + kstep, voffB); PG8_STAGE(PG8_SA(1, 0), cA + kstep, voffA); PG8_STAGE(PG8_SB(1, 1), cB + hstep + kstep, voffB);
        PG8_WAIT_V(6); PG8_BAR;
    } else {
        PG8_STAGE(PG8_SB(0, 0), cB, voffB); PG8_STAGE(PG8_SA(0, 0), cA, voffA); PG8_STAGE(PG8_SB(0, 1), cB + hstep, voffB); PG8_STAGE(PG8_SA(0, 1), cA + hstep, voffA);
        if (wr == 1) PG8_BAR;
        PG8_WAIT_V(4); PG8_BAR;
        PG8_STAGE(PG8_SB(1, 0), cB + kstep, voffB); PG8_STAGE(PG8_SA(1, 0), cA + kstep, voffA); PG8_STAGE(PG8_SB(1, 1), cB + hstep + kstep, voffB);
        PG8_WAIT_V(6); PG8_BAR;
    }
    for (;;) {
        const bool has_next = S.next(ui + 1, nxt);
        const char* nA = has_next ? (const char*)g.A + (size_t)nxt.pm * tstep : cA; const char* nB = has_next ? (const char*)g.Bt + (size_t)nxt.pn * tstep : cB;
        for (int t = 0; t < nt; t += 2) {
            const bool last = (t == nt - 2);
            const char* a1 = cA + (size_t)(t + 1) * kstep;
            const char* a2 = last ? nA : cA + (size_t)(t + 2) * kstep; const char* b2 = last ? nB : cB + (size_t)(t + 2) * kstep;
            const char* a3 = a2 + kstep; const char* b3 = b2 + kstep;
            if (last && has_next) S.a_ready(nxt);
            if constexpr (SP2) {
            PG8_LDB(B0, 0, 0); PG8_LDB(B1, 0, 1); PG8_SCHED; PG8_LDA(At, 0, 0); PG8_STAGE(PG8_SA(1, 1), a1 + hstep, voffA);
            PG8_WAIT_V(8); PG8_WAIT_L(0); PG8_BAR; PG8_MMA(0, 0, At, B0); PG8_MMA(0, 1, At, B1); PG8_BAR; PG8_SCHED;
            PG8_LDA(At, 0, 1); PG8_STAGE(PG8_SB(0, 0), b2, voffB); PG8_STAGE(PG8_SB(0, 1), b2 + hstep, voffB); PG8_STAGE(PG8_SA(0, 0), a2, voffA);
            PG8_WAIT_V(8); PG8_WAIT_L(0); PG8_BAR; PG8_MMA(1, 0, At, B0); PG8_MMA(1, 1, At, B1); PG8_BAR; PG8_SCHED;
            PG8_LDB(B0, 1, 0); PG8_LDB(B1, 1, 1); PG8_SCHED; PG8_LDA(At, 1, 0); PG8_STAGE(PG8_SA(0, 1), a2 + hstep, voffA);
            PG8_WAIT_V(8); PG8_WAIT_L(0); PG8_BAR; PG8_MMA(0, 0, At, B0); PG8_MMA(0, 1, At, B1); PG8_BAR; PG8_SCHED;
            PG8_LDA(At, 1, 1); PG8_STAGE(PG8_SB(1, 0), b3, voffB); PG8_STAGE(PG8_SB(1, 1), b3 + hstep, voffB); PG8_STAGE(PG8_SA(1, 0), a3, voffA);
            PG8_WAIT_V(8); PG8_WAIT_L(0); PG8_BAR; PG8_MMA(1, 0, At, B0); PG8_MMA(1, 1, At, B1); PG8_BAR; PG8_SCHED;
            } else {
            PG8_LDB(B0, 0, 0); PG8_SCHED; PG8_LDA(At, 0, 0); PG8_STAGE(PG8_SA(1, 1), a1 + hstep, voffA);
            PG8_WAIT_L(8); PG8_BAR; PG8_WAIT_L(0); PG8_MMA(0, 0, At, B0); PG8_BAR; PG8_SCHED;
            PG8_LDB(B1, 0, 1); PG8_STAGE(PG8_SB(0, 0), b2, voffB);
            PG8_BAR; PG8_WAIT_L(0); PG8_MMA(0, 1, At, B1); PG8_BAR;
            PG8_LDA(At, 0, 1); PG8_STAGE(PG8_SA(0, 0), a2, voffA);
            PG8_BAR; PG8_WAIT_L(0); PG8_MMA(1, 0, At, B0); PG8_BAR; PG8_SCHED;
            PG8_STAGE(PG8_SB(0, 1), b2 + hstep, voffB);
            PG8_WAIT_V(6); PG8_BAR; PG8_MMA(1, 1, At, B1); PG8_BAR;
            PG8_LDB(B0, 1, 0); PG8_SCHED; PG8_LDA(At, 1, 0); PG8_STAGE(PG8_SA(0, 1), a2 + hstep, voffA);
            PG8_WAIT_L(8); PG8_BAR; PG8_WAIT_L(0); PG8_MMA(0, 0, At, B0); PG8_BAR; PG8_SCHED;
            PG8_LDB(B1, 1, 1); PG8_STAGE(PG8_SB(1, 0), b3, voffB);
            PG8_BAR; PG8_WAIT_L(0); PG8_MMA(0, 1, At, B1); PG8_BAR;
            PG8_LDA(At, 1, 1); PG8_STAGE(PG8_SA(1, 0), a3, voffA);
            PG8_BAR; PG8_WAIT_L(0); PG8_MMA(1, 0, At, B0); PG8_BAR; PG8_SCHED;
            PG8_STAGE(PG8_SB(1, 1), b3 + hstep, voffB);
            PG8_WAIT_V(6); PG8_BAR; PG8_MMA(1, 1, At, B1); PG8_BAR;
            }
        }
        if constexpr (ALIGN_EPI) { if (wr == 0) PG8_BAR; }
        if constexpr (!Epi::AFTER_DRAIN) { E(acc, cur, wr, wc, fr, fq); S.done(cur); }
        if (!has_next) break;
#pragma unroll
        for (int a = 0; a < 2; ++a)
#pragma unroll
            for (int b = 0; b < 2; ++b)
#pragma unroll
                for (int m = 0; m < 4; ++m)
#pragma unroll
                    for (int n = 0; n < 2; ++n) acc[a][b][m][n] = (f32x4){0.f, 0.f, 0.f, 0.f};
        cur = nxt; cA = nA; cB = nB; ++ui;
        if constexpr (ALIGN_EPI) { if (wr == 1) PG8_BAR; }
    }
    PG8_WAIT_V(0);
    if constexpr (!ALIGN_EPI) { if (wr == 0) PG8_BAR; }
    PG8_BAR;
    if constexpr (Epi::AFTER_DRAIN) { E.fused(acc, cur, wr, wc, fr, fq, lds, wid, lane); S.done(cur); }
#undef PG8_SA
#undef PG8_SB
#undef PG8_STAGE
#undef PG8_LDA
#undef PG8_LDB
#undef PG8_MMA
#undef PG8_WAIT_V
#undef PG8_WAIT_L
#undef PG8_BAR
#undef PG8_SCHED
}
}

#define LAS __attribute__((address_space(3)))
typedef unsigned short bf16;
typedef short bf16x8 __attribute__((ext_vector_type(8)));
typedef float f32x4 __attribute__((ext_vector_type(4)));
typedef float f32x16 __attribute__((ext_vector_type(16)));
typedef unsigned u32x4 __attribute__((ext_vector_type(4)));
typedef unsigned u32x2 __attribute__((ext_vector_type(2)));
using pg8::cvtpk;
using pg8::silu_f;

constexpr int NT = 512;
constexpr int TT = 81920, DM = 1024, DFF = 2816, NPROJ = 3072, PROJ = 2832;
constexpr int SEQ0 = 16384, SEQS = 8192;
constexpr float ALPHA = 1.189207115002721f;
constexpr float LN_EPS = 1e-5f, RMS_EPS = 1e-6f;
constexpr float LOG2E = 1.4426950408889634f;
constexpr int LDS_BYTES = 147456;
constexpr size_t MiB = 1u << 20;
constexpr size_t WS_W1IN = 2 * MiB, WS_W1OUT = 13 * MiB, WS_WIN = 19 * MiB, WS_WOUT = 25 * MiB, WS_W2IN = 27 * MiB, WS_W2OUT = 38 * MiB;
constexpr size_t WS_XB = 44 * MiB;
constexpr size_t WS_P = 204 * MiB;
constexpr size_t WS_AQKV = 204 * MiB, WS_DQKV = 324 * MiB, WS_Z = 564 * MiB, WS_BA = 644 * MiB;
constexpr size_t WS_WF = 204 * MiB, WS_UF = 284 * MiB, WS_WB = 364 * MiB, WS_UB = 444 * MiB;
constexpr size_t WS_QN = 684 * MiB, WS_KN = 764 * MiB, WS_V2 = 844 * MiB, WS_OB = 924 * MiB, WS_GC = 1004 * MiB;
constexpr size_t WS_END = 1008 * MiB;

template <class V> __device__ __forceinline__ V lds_ld(LAS unsigned char* p, int off) { return *(LAS V*)(p + off); }
template <class V> __device__ __forceinline__ void lds_st(LAS unsigned char* p, int off, V v) { *(LAS V*)(p + off) = v; }
__device__ __forceinline__ float bf2f(unsigned short b) { return __uint_as_float((unsigned)b << 16); }
__device__ __forceinline__ float wave_sum(float v) {
#pragma unroll
    for (int o = 1; o < 64; o <<= 1) v += __shfl_xor(v, o);
    return v;
}
__device__ __forceinline__ int crow(int r, int hi) { return (r & 3) + 8 * (r >> 2) + 4 * hi; }
#define MFMA32(a, b, c) __builtin_amdgcn_mfma_f32_32x32x16_bf16((a), (b), (c), 0, 0, 0)
__device__ __forceinline__ void seq_of(int row, int& s0, int& L) { if (row < SEQ0) { s0 = 0; L = SEQ0; } else { s0 = SEQ0 + ((row - SEQ0) / SEQS) * SEQS; L = SEQS; } }

struct Params { const float* in[15]; float* out; unsigned char* ws; };

__device__ __forceinline__ void p0_transpose_item(const float* W, int K, int N, int Npad, bf16* WT, int mode, LAS float* scr, int item, int lane) {
    const int nblk = Npad / 32, kb = item / nblk, nb = item % nblk, k0 = 64 * kb, n0 = 32 * nb;
    const int nn = n0 + (lane & 31);
#pragma unroll 8
    for (int i = 0; i < 32; ++i) { const int kk = 2 * i + (lane >> 5); scr[kk * 33 + (lane & 31)] = (nn < N) ? W[(size_t)(k0 + kk) * N + nn] : 0.f; }
    asm volatile("s_waitcnt lgkmcnt(0)" ::: "memory");
    int r0 = n0;
    if (mode == 1) { const int up = n0 >= DFF ? 1 : 0; const int j0 = n0 - up * DFF; r0 = (j0 >> 7) * 256 + up * 128 + (j0 & 127); }
    const int c = lane & 7;
#pragma unroll
    for (int j = 0; j < 4; ++j) { const int n = (lane >> 3) + 8 * j; const LAS float* s = scr + (8 * c) * 33 + n;
        u32x4 o; o.x = cvtpk(s[0 * 33], s[1 * 33]); o.y = cvtpk(s[2 * 33], s[3 * 33]); o.z = cvtpk(s[4 * 33], s[5 * 33]); o.w = cvtpk(s[6 * 33], s[7 * 33]);
        *(u32x4*)(WT + (size_t)(r0 + n) * K + k0 + 8 * c) = o; }
    asm volatile("s_waitcnt lgkmcnt(0)" ::: "memory");
}
__device__ __forceinline__ void phase_p0(const Params& P, LAS unsigned char* lds, int gw, int NGW, int wave, int lane) {
    LAS float* scr = (LAS float*)(lds + wave * 16384);
    unsigned char* ws = P.ws;
    constexpr int I_1IN = (DM / 64) * (2 * DFF / 32), I_1OUT = (DFF / 64) * (DM / 32), I_IN = (DM / 64) * (NPROJ / 32), I_OUT = (DM / 64) * (DM / 32);
    constexpr int NITEMS = 2 * I_1IN + 2 * I_1OUT + I_IN + I_OUT;
    for (int it = gw; it < NITEMS; it += NGW) {
        int r = it;
        if (r < I_1IN) { p0_transpose_item(P.in[2], DM, 2 * DFF, 2 * DFF, (bf16*)(ws + WS_W1IN), 1, scr, r, lane); continue; } r -= I_1IN;
        if (r < I_1IN) { p0_transpose_item(P.in[11], DM, 2 * DFF, 2 * DFF, (bf16*)(ws + WS_W2IN), 1, scr, r, lane); continue; } r -= I_1IN;
        if (r < I_1OUT) { p0_transpose_item(P.in[3], DFF, DM, DM, (bf16*)(ws + WS_W1OUT), 0, scr, r, lane); continue; } r -= I_1OUT;
        if (r < I_1OUT) { p0_transpose_item(P.in[12], DFF, DM, DM, (bf16*)(ws + WS_W2OUT), 0, scr, r, lane); continue; } r -= I_1OUT;
        if (r < I_IN) { p0_transpose_item(P.in[4], DM, PROJ, NPROJ, (bf16*)(ws + WS_WIN), 0, scr, r, lane); continue; } r -= I_IN;
        p0_transpose_item(P.in[10], DM, DM, DM, (bf16*)(ws + WS_WOUT), 0, scr, r, lane);
    }
    bf16* XB = (bf16*)(ws + WS_XB);
    for (int m = gw; m < TT; m += NGW) {
        const float* xr = (m < SEQ0) ? P.in[0] + (size_t)m * DM : P.in[1] + (size_t)(m - SEQ0) * DM;
#pragma unroll
        for (int j = 0; j < 4; ++j) { const f32x4 v = *((const f32x4*)xr + lane + 64 * j); u32x2 o; o.x = cvtpk(v.x, v.y); o.y = cvtpk(v.z, v.w); *((u32x2*)(XB + (size_t)m * DM) + lane + 64 * j) = o; }
    }
}

__device__ __forceinline__ void phase_ln(float* io, bf16* XB, const float* gain, const float* bias, bool wr_bf, int gw, int NGW, int lane) {
    f32x4 gv[4], bv[4];
#pragma unroll
    for (int j = 0; j < 4; ++j) { gv[j] = *((const f32x4*)gain + lane + 64 * j); bv[j] = *((const f32x4*)bias + lane + 64 * j); }
    for (int m = gw; m < TT; m += NGW) {
        f32x4* xr = (f32x4*)(io + (size_t)m * DM) + lane;
        f32x4 v[4]; float s = 0.f;
#pragma unroll
        for (int j = 0; j < 4; ++j) { v[j] = xr[64 * j]; s += (v[j].x + v[j].y) + (v[j].z + v[j].w); }
        const float mean = wave_sum(s) * (1.f / DM); float s2 = 0.f;
#pragma unroll
        for (int j = 0; j < 4; ++j) { v[j] = v[j] - mean; s2 += (v[j].x * v[j].x + v[j].y * v[j].y) + (v[j].z * v[j].z + v[j].w * v[j].w); }
        const float rstd = 1.f / sqrtf(wave_sum(s2) * (1.f / DM) + LN_EPS);
#pragma unroll
        for (int j = 0; j < 4; ++j) { const f32x4 y = v[j] * rstd * gv[j] + bv[j]; xr[64 * j] = y;
            if (wr_bf) { u32x2 o; o.x = cvtpk(y.x, y.y); o.y = cvtpk(y.z, y.w); *((u32x2*)(XB + (size_t)m * DM) + lane + 64 * j) = o; } }
    }
}

constexpr int AT_KSTR = 144;
constexpr int AT_VSTR = 784;
constexpr int AT_K = 0, AT_V = 384 * AT_KSTR;
__device__ __forceinline__ void phase_attn(const bf16* AQKV, bf16* XB, const float* sink, LAS unsigned char* lds, int tid, int wave, int lane) {
    const int ql = lane & 31, hi = lane >> 5;
    for (int unit = blockIdx.x; unit < (TT / 128) * 2; unit += gridDim.x) {
        const int blk = unit >> 1, kvh = unit & 1, r0 = blk * 128;
        int s0, L; seq_of(r0, s0, L);
        __syncthreads();
        for (int c = tid; c < 384 * 8; c += NT) {
            const int kk = c >> 3, ch = c & 7, arow = r0 - 128 + kk;
            const bool valid = arow >= s0 && arow < s0 + L;
            u32x4 kv = {0u, 0u, 0u, 0u}, vv = {0u, 0u, 0u, 0u};
            if (valid) { const bf16* rp = AQKV + (size_t)arow * 768 + 64 * kvh + 8 * ch; kv = *(const u32x4*)(rp + 512); vv = *(const u32x4*)(rp + 640); }
            lds_st<u32x4>(lds, AT_K + kk * AT_KSTR + ch * 16, kv);
#pragma unroll
            for (int e = 0; e < 8; ++e) { const unsigned w = vv[e >> 1]; lds_st<unsigned short>(lds, AT_V + (8 * ch + e) * AT_VSTR + kk * 2, (unsigned short)((e & 1) ? (w >> 16) : (w & 0xffffu))); }
        }
        __syncthreads();
#pragma unroll 1
        for (int gi = 0; gi < 2; ++gi) {
            const int gq = wave * 2 + gi, hl = gq >> 2, qq = gq & 3, hq = 4 * kvh + hl;
            const int qrow = r0 + 32 * qq + ql;
            bf16x8 qf[4];
#pragma unroll
            for (int ks = 0; ks < 4; ++ks) qf[ks] = *(const bf16x8*)(AQKV + (size_t)qrow * 768 + 64 * hq + 16 * ks + 8 * hi);
            const float slope2 = exp2f(-(float)(hq + 1)) * LOG2E;
            float m = sink[hq] * LOG2E, l = 1.0f;
            f32x16 o0, o1;
#pragma unroll
            for (int r = 0; r < 16; ++r) { o0[r] = 0.f; o1[r] = 0.f; }
#pragma unroll 1
            for (int jt = qq; jt <= qq + 8; ++jt) {
                f32x16 s;
#pragma unroll
                for (int r = 0; r < 16; ++r) s[r] = 0.f;
#pragma unroll
                for (int ks = 0; ks < 4; ++ks) { const bf16x8 kf = lds_ld<bf16x8>(lds, AT_K + (32 * jt + ql) * AT_KSTR + (16 * ks + 8 * hi) * 2); s = MFMA32(kf, qf[ks], s); }
                float mx = m;
#pragma unroll
                for (int r = 0; r < 16; ++r) {
                    const int kk = 32 * jt + crow(r, hi); const int dist = 128 + 32 * qq + ql - kk; const int ad = dist < 0 ? -dist : dist; const int arow = r0 - 128 + kk;
                    const bool valid = (ad <= 128) && (arow >= s0) && (arow < s0 + L);
                    const float lg = valid ? (s[r] * (0.125f * LOG2E) - slope2 * (float)ad) : -INFINITY;
                    s[r] = lg; mx = fmaxf(mx, lg);
                }
                mx = fmaxf(mx, __shfl_xor(mx, 32));
                const float corr = exp2f(m - mx); m = mx;
                float rs = 0.f;
#pragma unroll
                for (int r = 0; r < 16; ++r) { const float p = exp2f(s[r] - mx); s[r] = p; rs += p; }
                rs += __shfl_xor(rs, 32);
                l = l * corr + rs;
#pragma unroll
                for (int r = 0; r < 16; ++r) { o0[r] *= corr; o1[r] *= corr; }
#pragma unroll
                for (int si = 0; si < 2; ++si) {
                    u32x4 pw; pw.x = cvtpk(s[8 * si + 0], s[8 * si + 1]); pw.y = cvtpk(s[8 * si + 2], s[8 * si + 3]); pw.z = cvtpk(s[8 * si + 4], s[8 * si + 5]); pw.w = cvtpk(s[8 * si + 6], s[8 * si + 7]);
                    const bf16x8 pb = __builtin_bit_cast(bf16x8, pw);
                    const int kofs = (32 * jt + 16 * si + 4 * hi) * 2;
                    { const u32x2 lo = lds_ld<u32x2>(lds, AT_V + ql * AT_VSTR + kofs), hh = lds_ld<u32x2>(lds, AT_V + ql * AT_VSTR + kofs + 16);
                      u32x4 va; va.x = lo.x; va.y = lo.y; va.z = hh.x; va.w = hh.y; o0 = MFMA32(__builtin_bit_cast(bf16x8, va), pb, o0); }
                    { const u32x2 lo = lds_ld<u32x2>(lds, AT_V + (32 + ql) * AT_VSTR + kofs), hh = lds_ld<u32x2>(lds, AT_V + (32 + ql) * AT_VSTR + kofs + 16);
                      u32x4 va; va.x = lo.x; va.y = lo.y; va.z = hh.x; va.w = hh.y; o1 = MFMA32(__builtin_bit_cast(bf16x8, va), pb, o1); }
                }
            }
            const float inv = 1.0f / l;
            bf16* orow = XB + (size_t)qrow * DM + 64 * hq + 4 * hi;
#pragma unroll
            for (int g = 0; g < 4; ++g) {
                u32x2 w0, w1;
                w0.x = cvtpk(o0[4 * g] * inv, o0[4 * g + 1] * inv); w0.y = cvtpk(o0[4 * g + 2] * inv, o0[4 * g + 3] * inv);
                w1.x = cvtpk(o1[4 * g] * inv, o1[4 * g + 1] * inv); w1.y = cvtpk(o1[4 * g + 2] * inv, o1[4 * g + 3] * inv);
                *(u32x2*)(orow + 8 * g) = w0; *(u32x2*)(orow + 32 + 8 * g) = w1;
            }
        }
    }
}

__device__ __forceinline__ void phase_conv(const bf16* DQKV, const float* convw, bf16* QN, bf16* KN, bf16* V2, int gw, int NGW, int lane) {
    for (int item = gw; item < (TT / 8) * 12; item += NGW) {
        const int tg = item / 12, ph = item - tg * 12, p = ph >> 2, h = ph & 3, t0 = tg * 8;
        int s0, L; seq_of(t0, s0, L);
        const int col = p * 512 + h * 128 + 2 * lane;
        float w0[5], w1[5];
#pragma unroll
        for (int j = 0; j < 5; ++j) { const pg8::f32x2 wv = *(const pg8::f32x2*)(convw + j * 1536 + col); w0[j] = wv.x; w1[j] = wv.y; }
        float x0[12], x1[12];
#pragma unroll
        for (int i = 0; i < 12; ++i) { const int t = t0 - 2 + i; unsigned u = 0u; if (t >= s0 && t < s0 + L) u = *(const unsigned*)(DQKV + (size_t)t * 1536 + col); x0[i] = bf2f((unsigned short)(u & 0xffffu)); x1[i] = bf2f((unsigned short)(u >> 16)); }
        bf16* dst = (p == 0) ? QN : (p == 1 ? KN : V2);
#pragma unroll
        for (int tt = 0; tt < 8; ++tt) {
            float y0 = 0.f, y1 = 0.f;
#pragma unroll
            for (int j = 0; j < 5; ++j) { y0 += w0[j] * x0[tt + j]; y1 += w1[j] * x1[tt + j]; }
            y0 = silu_f(y0); y1 = silu_f(y1);
            if (p < 2) { const float ss = wave_sum(y0 * y0 + y1 * y1); const float sc = rsqrtf(ss + RMS_EPS) * (p == 0 ? 0.08838834764831845f : 1.0f); y0 *= sc; y1 *= sc; }
            const int t = t0 + tt;
            *(unsigned*)(dst + ((size_t)(t >> 6) * 4 + h) * 8192 + (t & 63) * 128 + 2 * lane) = cvtpk(y0, y1);
        }
    }
}

constexpr int PB_QS = 0, PB_KS = 17408, PB_GK = 34816, PB_GQ = 51456, PB_KT = 68096, PB_VT = 86528, PB_MP = 104960, PB_SM = 139776;
constexpr int PB_TT = 0;
__device__ __forceinline__ void phase_prepb(const Params& P, LAS unsigned char* lds, int tid0, int wave, int lane0) {
    unsigned char* ws = P.ws;
    const bf16* QN = (const bf16*)(ws + WS_QN); bf16* KN = (bf16*)(ws + WS_KN); bf16* V2 = (bf16*)(ws + WS_V2);
    const float* BA = (const float*)(ws + WS_BA); float* GC = (float*)(ws + WS_GC);
    for (int unit = blockIdx.x; unit < (TT / 64) * 4; unit += gridDim.x) {
        int zz; asm volatile("v_mov_b32 %0, 0" : "=v"(zz));
        const int tid = tid0 + zz, lane = lane0 + zz, ql = lane & 31, hi = lane >> 5;
        const int cidx = unit >> 2, h = unit & 3, row0 = cidx * 64;
        const size_t slot = (size_t)unit * 8192;
        __syncthreads();
#pragma unroll
        for (int i = 0; i < 2; ++i) {
            const int c = tid + i * NT, row = c >> 4, ch = c & 15;
            const u32x4 qv = *(const u32x4*)(QN + slot + row * 128 + 8 * ch), kv = *(const u32x4*)(KN + slot + row * 128 + 8 * ch), vv = *(const u32x4*)(V2 + slot + row * 128 + 8 * ch);
            lds_st<u32x4>(lds, PB_QS + row * 272 + ch * 16, qv); lds_st<u32x4>(lds, PB_KS + row * 272 + ch * 16, kv);
#pragma unroll
            for (int e = 0; e < 8; ++e) {
                const unsigned wk = kv[e >> 1], wv = vv[e >> 1];
                lds_st<unsigned short>(lds, PB_KT + (8 * ch + e) * 144 + row * 2, (unsigned short)((e & 1) ? (wk >> 16) : (wk & 0xffffu)));
                lds_st<unsigned short>(lds, PB_VT + (8 * ch + e) * 144 + row * 2, (unsigned short)((e & 1) ? (wv >> 16) : (wv & 0xffffu)));
            }
        }
        if (tid < 128) {
            const int d = tid >> 6, i = tid & 63;
            const float bval = BA[(size_t)(row0 + i) * 16 + 4 * d + h], aval = BA[(size_t)(row0 + i) * 16 + 8 + 4 * d + h];
            const float beta = 1.0f / (1.0f + __expf(-bval));
            const float xs = aval + P.in[8][4 * d + h];
            const float sp = xs > 20.f ? xs : log1pf(__expf(xs));
            float g = -__expf(P.in[7][4 * d + h]) * sp;
#pragma unroll
            for (int o = 1; o < 64; o <<= 1) { const float up = __shfl_up(g, o), dn = __shfl_down(g, o); if (d == 0) { if (i >= o) g += up; } else { if (i + o < 64) g += dn; } }
            lds_st<float>(lds, PB_SM + (d * 64 + i) * 4, beta);
            lds_st<float>(lds, PB_SM + 512 + (d * 64 + i) * 4, g);
            lds_st<float>(lds, PB_SM + 1024 + (d * 64 + i) * 4, beta * __expf(g));
            GC[((size_t)d * TT + row0 + i) * 4 + h] = g;
        }
        __syncthreads();
        {
            const int mat = wave >> 2, rt = (wave >> 1) & 1, ct = wave & 1;
            const int xs = mat ? PB_QS : PB_KS;
            f32x16 acc;
#pragma unroll
            for (int r = 0; r < 16; ++r) acc[r] = 0.f;
#pragma unroll
            for (int ks = 0; ks < 8; ++ks) { const bf16x8 a = lds_ld<bf16x8>(lds, xs + (32 * rt + ql) * 272 + (16 * ks + 8 * hi) * 2), b = lds_ld<bf16x8>(lds, PB_KS + (32 * ct + ql) * 272 + (16 * ks + 8 * hi) * 2); acc = MFMA32(a, b, acc); }
            const int go = mat ? PB_GQ : PB_GK;
#pragma unroll
            for (int r = 0; r < 16; ++r) lds_st<float>(lds, go + ((32 * rt + crow(r, hi)) * 65 + 32 * ct + ql) * 4, acc[r]);
        }
        __syncthreads();
        {
            const int i = tid >> 3, jb = (tid & 7) * 8;
#pragma unroll
            for (int d = 0; d < 2; ++d) {
                const float gi = lds_ld<float>(lds, PB_SM + 512 + (d * 64 + i) * 4), bi = lds_ld<float>(lds, PB_SM + (d * 64 + i) * 4);
                float av[8];
#pragma unroll
                for (int e = 0; e < 8; ++e) {
                    const int j = jb + e; const bool strict = d ? (j > i) : (j < i); const bool incl = strict || (j == i);
                    const float gj = lds_ld<float>(lds, PB_SM + 512 + (d * 64 + j) * 4);
                    const float dec = __expf(incl ? gi - gj : 0.f);
                    const float gk = lds_ld<float>(lds, PB_GK + (i * 65 + j) * 4), gq = lds_ld<float>(lds, PB_GQ + (i * 65 + j) * 4);
                    const float mv = strict ? bi * gk * dec : 0.f; av[e] = incl ? gq * dec : 0.f;
                    const int ip = d ? 63 - i : i, jp = d ? 63 - j : j;
                    lds_st<float>(lds, PB_MP + ((d * 64 + ip) * 68 + jp) * 4, mv);
                }
                u32x4 w; w.x = cvtpk(av[0], av[1]); w.y = cvtpk(av[2], av[3]); w.z = cvtpk(av[4], av[5]); w.w = cvtpk(av[6], av[7]);
                *(u32x4*)(V2 + slot + d * 4096 + i * 64 + jb) = w;
            }
        }
        __syncthreads();
        if (wave < 4) {
            const int d = wave >> 1, blk = wave & 1, cl = lane & 31;
            int mbv; asm volatile("v_mov_b32 %0, %1" : "=v"(mbv) : "s"(PB_MP + d * 64 * 68 * 4 + blk * 32 * 69 * 4));
            float tc[32];
#pragma unroll
            for (int i = 0; i < 32; ++i) {
                float acc = (cl == i) ? 1.f : 0.f;
#pragma unroll
                for (int kq = 0; kq < (i + 3) / 4; ++kq) {
                    const f32x4 mv = lds_ld<f32x4>(lds, mbv + (i * 68 + 4 * kq) * 4);
#pragma unroll
                    for (int e = 0; e < 4; ++e) if (4 * kq + e < i) acc -= mv[e] * tc[4 * kq + e];
                }
                tc[i] = acc;
                asm volatile("" : "+v"(tc[i]) :: "memory");
            }
            if (lane < 32) {
#pragma unroll
                for (int i = 0; i < 32; ++i) lds_st<float>(lds, mbv + (i * 68 + cl) * 4, tc[i]);
            }
        }
        __syncthreads();
        if (wave < 2) {
            const int d = wave; const int mb = PB_MP + d * 64 * 68 * 4;
            f32x16 X, Y;
#pragma unroll
            for (int r = 0; r < 16; ++r) { X[r] = 0.f; Y[r] = 0.f; }
#pragma unroll
            for (int s2 = 0; s2 < 16; ++s2) { const float a = lds_ld<float>(lds, mb + ((32 + ql) * 68 + 2 * s2 + hi) * 4), bq = lds_ld<float>(lds, mb + ((2 * s2 + hi) * 68 + ql) * 4); X = __builtin_amdgcn_mfma_f32_32x32x2f32(a, bq, X, 0, 0, 0); }
#pragma unroll
            for (int s2 = 0; s2 < 16; ++s2) { const float a = lds_ld<float>(lds, mb + ((32 + ql) * 68 + 32 + crow(s2, hi)) * 4); Y = __builtin_amdgcn_mfma_f32_32x32x2f32(a, X[s2], Y, 0, 0, 0); }
            asm volatile("s_waitcnt lgkmcnt(0)" ::: "memory");
#pragma unroll
            for (int r = 0; r < 16; ++r) lds_st<float>(lds, mb + ((32 + crow(r, hi)) * 68 + ql) * 4, -Y[r]);
        }
        __syncthreads();
        {
            const int d = tid >> 8, i = (tid >> 2) & 63, kb = (tid & 3) * 16;
            const int ip = d ? 63 - i : i; const int mb = PB_MP + d * 64 * 68 * 4;
            float tu[16], tw[16];
#pragma unroll
            for (int x = 0; x < 16; ++x) { const int k = kb + x, kp = d ? 63 - k : k; const float tv = lds_ld<float>(lds, mb + (ip * 68 + kp) * 4);
                const float su = lds_ld<float>(lds, PB_SM + (d * 64 + k) * 4), sw = lds_ld<float>(lds, PB_SM + 1024 + (d * 64 + k) * 4); tu[x] = tv * su; tw[x] = tv * sw; }
#pragma unroll
            for (int hq = 0; hq < 2; ++hq) {
                u32x4 a, b;
#pragma unroll
                for (int x = 0; x < 4; ++x) { a[x] = cvtpk(tu[8 * hq + 2 * x], tu[8 * hq + 2 * x + 1]); b[x] = cvtpk(tw[8 * hq + 2 * x], tw[8 * hq + 2 * x + 1]); }
                lds_st<u32x4>(lds, PB_TT + (2 * d) * 9216 + i * 144 + (kb + 8 * hq) * 2, a); lds_st<u32x4>(lds, PB_TT + (2 * d + 1) * 9216 + i * 144 + (kb + 8 * hq) * 2, b);
            }
        }
        __syncthreads();
        {
            const int d = wave >> 2, pt = (wave >> 1) & 1, rt = wave & 1;
            bf16x8 tf[4];
#pragma unroll
            for (int ks = 0; ks < 4; ++ks) tf[ks] = lds_ld<bf16x8>(lds, PB_TT + (2 * d + pt) * 9216 + (32 * rt + ql) * 144 + (16 * ks + 8 * hi) * 2);
            bf16* dstb = (bf16*)(ws + (pt == 0 ? (d ? WS_UB : WS_UF) : (d ? WS_WB : WS_WF))) + slot;
            const int xo = pt == 0 ? PB_VT : PB_KT;
#pragma unroll 1
            for (int ct = 0; ct < 4; ++ct) {
                f32x16 acc;
#pragma unroll
                for (int r = 0; r < 16; ++r) acc[r] = 0.f;
#pragma unroll
                for (int ks = 0; ks < 4; ++ks) { const bf16x8 xf = lds_ld<bf16x8>(lds, xo + (32 * ct + ql) * 144 + (16 * ks + 8 * hi) * 2); acc = (pt == 0) ? MFMA32(tf[ks], xf, acc) : MFMA32(xf, tf[ks], acc); }
#pragma unroll
                for (int g = 0; g < 4; ++g) {
                    u32x2 w; w.x = cvtpk(acc[4 * g], acc[4 * g + 1]); w.y = cvtpk(acc[4 * g + 2], acc[4 * g + 3]);
                    if (pt == 0) *(u32x2*)(dstb + (32 * ct + ql) * 64 + 32 * rt + 8 * g + 4 * hi) = w;
                    else *(u32x2*)(dstb + (32 * rt + ql) * 128 + 32 * ct + 8 * g + 4 * hi) = w;
                }
            }
#pragma unroll
            for (int i = 0; i < 2; ++i) { const int c = tid + i * NT, dk = c >> 3, ch = c & 7; *(u32x4*)(KN + slot + dk * 64 + 8 * ch) = lds_ld<u32x4>(lds, PB_KT + dk * 144 + ch * 16); }
        }
    }
}

constexpr int SC_W = 0, SC_Q = 16384, SC_KT = 32768, SC_A = 49152, SC_UT = 57344, SC_GC = 61440, SC_BUF = 61696;
constexpr int SC_ST = 2 * SC_BUF, SC_V1 = SC_ST + 8192, SC_V2 = SC_V1 + 4096;
__device__ __forceinline__ int sw256(int row, int ch) { return row * 256 + ((ch ^ (row & 15)) << 4); }
__device__ __forceinline__ int sw128(int row, int ch) { return row * 128 + ((ch ^ (row & 7)) << 4); }
struct ScanRegs { u32x4 w[2], q[2], kt[2], a, ut; float gc; };
__device__ __forceinline__ void scan_load(ScanRegs& R, const unsigned char* ws, int cidx, int h, int d, int e, int tid) {
    const size_t slot = ((size_t)cidx * 4 + h) * 8192;
    const bf16* Wp = (const bf16*)(ws + (d ? WS_WB : WS_WF)) + slot; const bf16* Qp = (const bf16*)(ws + WS_QN) + slot; const bf16* Kp = (const bf16*)(ws + WS_KN) + slot;
    const bf16* Ap = (const bf16*)(ws + WS_V2) + slot + d * 4096; const bf16* Up = (const bf16*)(ws + (d ? WS_UB : WS_UF)) + slot + (32 * e) * 64;
#pragma unroll
    for (int i = 0; i < 2; ++i) { const int c = tid + i * NT; R.w[i] = *(const u32x4*)(Wp + c * 8); R.q[i] = *(const u32x4*)(Qp + c * 8); R.kt[i] = *(const u32x4*)(Kp + c * 8); }
    R.a = *(const u32x4*)(Ap + tid * 8);
    if (tid < 256) R.ut = *(const u32x4*)(Up + tid * 8);
    if (tid < 64) R.gc = ((const float*)(ws + WS_GC))[((size_t)d * TT + (size_t)cidx * 64 + tid) * 4 + h];
}
__device__ __forceinline__ void scan_store(const ScanRegs& R, LAS unsigned char* lds, int buf, int tid) {
    const int b = buf * SC_BUF;
#pragma unroll
    for (int i = 0; i < 2; ++i) { const int c = tid + i * NT;
        lds_st<u32x4>(lds, b + SC_W + sw256(c >> 4, c & 15), R.w[i]); lds_st<u32x4>(lds, b + SC_Q + sw256(c >> 4, c & 15), R.q[i]); lds_st<u32x4>(lds, b + SC_KT + sw128(c >> 3, c & 7), R.kt[i]); }
    lds_st<u32x4>(lds, b + SC_A + sw128(tid >> 3, tid & 7), R.a);
    if (tid < 256) lds_st<u32x4>(lds, b + SC_UT + sw128(tid >> 3, tid & 7), R.ut);
    if (tid < 64) lds_st<float>(lds, b + SC_GC + tid * 4, R.gc);
}
__device__ __forceinline__ void phase_scan(const Params& P, LAS unsigned char* lds, int tid, int wave, int lane) {
    unsigned char* ws = P.ws;
    bf16* XB = (bf16*)(ws + WS_XB); bf16* OB = (bf16*)(ws + WS_OB);
    const int ql = lane & 31, hi = lane >> 5;
    for (int it = blockIdx.x; it < 288; it += gridDim.x) {
        int seq, rem;
        if (it < 224) { seq = 1 + (it >> 5); rem = it & 31; } else if (it < 256) { seq = 0; rem = it - 224; } else { const int sc = it - 32; seq = 1 + (sc >> 5); rem = sc & 31; }
        const int h = rem >> 3, d = (rem >> 2) & 1, e = rem & 3;
        const int s0 = seq == 0 ? 0 : SEQ0 + (seq - 1) * SEQS, L = seq == 0 ? SEQ0 : SEQS, nc = L / 64, c0 = s0 / 64;
        __syncthreads();
        f32x16 S;
#pragma unroll
        for (int r = 0; r < 16; ++r) S[r] = 0.f;
        for (int i = tid; i < 8192 / 16; i += NT) lds_st<u32x4>(lds, SC_ST + i * 16, (u32x4){0u, 0u, 0u, 0u});
        ScanRegs R;
        scan_load(R, ws, c0 + (d ? nc - 1 : 0), h, d, e, tid);
        scan_store(R, lds, 0, tid);
        __syncthreads();
#pragma unroll 1
        for (int t = 0; t < nc; ++t) {
            const int cidx = c0 + (d ? nc - 1 - t : t), row0 = cidx * 64;
            const int b = (t & 1) * SC_BUF;
            if (t + 1 < nc) scan_load(R, ws, c0 + (d ? nc - 2 - t : t + 1), h, d, e, tid);
            const float gcl = lds_ld<float>(lds, b + SC_GC + (d ? 0 : 63) * 4);
            f32x16 acc;
#pragma unroll
            for (int r = 0; r < 16; ++r) acc[r] = 0.f;
            const int rt = wave & 1;
            if (wave < 4) {
                const int ao = b + (wave < 2 ? SC_W : SC_Q);
#pragma unroll
                for (int ks = 0; ks < 8; ++ks) { const bf16x8 a = lds_ld<bf16x8>(lds, ao + sw256(32 * rt + ql, 2 * ks + hi)), bb = lds_ld<bf16x8>(lds, SC_ST + sw256(ql, 2 * ks + hi)); acc = MFMA32(a, bb, acc); }
            }
            if (wave < 2) {
#pragma unroll
                for (int g = 0; g < 4; ++g) {
                    const int tk = 32 * rt + 8 * g + 4 * hi;
                    const u32x2 uu = lds_ld<u32x2>(lds, b + SC_UT + sw128(ql, tk >> 3) + (tk & 7) * 2);
                    const f32x4 gcv = lds_ld<f32x4>(lds, b + SC_GC + tk * 4);
                    const float v0 = bf2f((unsigned short)(uu.x & 0xffffu)) - acc[4 * g], v1 = bf2f((unsigned short)(uu.x >> 16)) - acc[4 * g + 1];
                    const float v2 = bf2f((unsigned short)(uu.y & 0xffffu)) - acc[4 * g + 2], v3 = bf2f((unsigned short)(uu.y >> 16)) - acc[4 * g + 3];
                    u32x2 w1, w2; w1.x = cvtpk(v0, v1); w1.y = cvtpk(v2, v3);
                    w2.x = cvtpk(v0 * __expf(gcl - gcv[0]), v1 * __expf(gcl - gcv[1])); w2.y = cvtpk(v2 * __expf(gcl - gcv[2]), v3 * __expf(gcl - gcv[3]));
                    lds_st<u32x2>(lds, SC_V1 + sw128(ql, tk >> 3) + (tk & 7) * 2, w1); lds_st<u32x2>(lds, SC_V2 + sw128(ql, tk >> 3) + (tk & 7) * 2, w2);
                }
            }
            __syncthreads();
            if (wave == 2 || wave == 3) {
#pragma unroll
                for (int g = 0; g < 4; ++g) { const int tk = 32 * rt + 8 * g + 4 * hi; const f32x4 gcv = lds_ld<f32x4>(lds, b + SC_GC + tk * 4);
#pragma unroll
                    for (int x = 0; x < 4; ++x) acc[4 * g + x] *= __expf(gcv[x]); }
#pragma unroll
                for (int ks = 0; ks < 4; ++ks) { const bf16x8 a = lds_ld<bf16x8>(lds, b + SC_A + sw128(32 * rt + ql, 2 * ks + hi)), bb = lds_ld<bf16x8>(lds, SC_V1 + sw128(ql, 2 * ks + hi)); acc = MFMA32(a, bb, acc); }
                bf16* op = d ? OB + (size_t)row0 * 512 + 128 * h + 32 * e + ql : XB + (size_t)row0 * DM + 512 + 128 * h + 32 * e + ql;
                const int ost = d ? 512 : DM;
#pragma unroll
                for (int r = 0; r < 16; ++r) op[(size_t)(32 * rt + crow(r, hi)) * ost] = (bf16)(cvtpk(acc[r], 0.f) & 0xffffu);
            } else if (wave >= 4) {
                const int dkt = wave - 4; const float gl = __expf(gcl);
#pragma unroll
                for (int r = 0; r < 16; ++r) S[r] *= gl;
#pragma unroll
                for (int ks = 0; ks < 4; ++ks) { const bf16x8 a = lds_ld<bf16x8>(lds, b + SC_KT + sw128(32 * dkt + ql, 2 * ks + hi)), bb = lds_ld<bf16x8>(lds, SC_V2 + sw128(ql, 2 * ks + hi)); S = MFMA32(a, bb, S); }
#pragma unroll
                for (int g = 0; g < 4; ++g) { u32x2 w; w.x = cvtpk(S[4 * g], S[4 * g + 1]); w.y = cvtpk(S[4 * g + 2], S[4 * g + 3]); const int dk = 32 * dkt + 8 * g + 4 * hi; lds_st<u32x2>(lds, SC_ST + sw256(ql, dk >> 3) + (dk & 7) * 2, w); }
            }
            if (t + 1 < nc) scan_store(R, lds, (t + 1) & 1, tid);
            __syncthreads();
        }
    }
}

__device__ __forceinline__ void phase_gate(const Params& P, int gw, int NGW, int lane) {
    unsigned char* ws = P.ws;
    bf16* XB = (bf16*)(ws + WS_XB); const bf16* OB = (const bf16*)(ws + WS_OB); const bf16* Z = (const bf16*)(ws + WS_Z);
    float gn[8];
#pragma unroll
    for (int x = 0; x < 8; ++x) gn[x] = P.in[9][8 * (lane & 15) + x];
    for (int m = gw; m < TT; m += NGW) {
        bf16* xp = XB + (size_t)m * DM + 512 + 8 * lane;
        const u32x4 a = *(const u32x4*)xp, b = *(const u32x4*)(OB + (size_t)m * 512 + 8 * lane), z = *(const u32x4*)(Z + (size_t)m * 512 + 8 * lane);
        float o[8]; float ss = 0.f;
#pragma unroll
        for (int x = 0; x < 4; ++x) { o[2 * x] = bf2f((unsigned short)(a[x] & 0xffffu)) + bf2f((unsigned short)(b[x] & 0xffffu)); o[2 * x + 1] = bf2f((unsigned short)(a[x] >> 16)) + bf2f((unsigned short)(b[x] >> 16)); ss += o[2 * x] * o[2 * x] + o[2 * x + 1] * o[2 * x + 1]; }
        ss += __shfl_xor(ss, 1); ss += __shfl_xor(ss, 2); ss += __shfl_xor(ss, 4); ss += __shfl_xor(ss, 8);
        const float rs = rsqrtf(ss * (1.0f / 128.0f) + RMS_EPS);
        u32x4 w;
#pragma unroll
        for (int x = 0; x < 4; ++x) { const float z0 = bf2f((unsigned short)(z[x] & 0xffffu)), z1 = bf2f((unsigned short)(z[x] >> 16)); w[x] = cvtpk(o[2 * x] * rs * gn[2 * x] * silu_f(z0), o[2 * x + 1] * rs * gn[2 * x + 1] * silu_f(z1)); }
        *(u32x4*)xp = w;
    }
}

__global__ void __launch_bounds__(NT, 2) fwd_megakernel(Params P) {
    extern __shared__ __attribute__((aligned(16))) unsigned char lds_raw[];
    LAS unsigned char* lds = (LAS unsigned char*)lds_raw;
    cg::grid_group grid = cg::this_grid();
    const int tid = threadIdx.x, lane = tid & 63, wave = __builtin_amdgcn_readfirstlane(tid >> 6);
    const int G = gridDim.x, gw = blockIdx.x * 8 + wave, NGW = G * 8;
    unsigned char* ws = P.ws;
    bf16* XB = (bf16*)(ws + WS_XB); bf16* H = (bf16*)(ws + WS_P);
    float* out = P.out;

#ifndef SKIP_P0
    phase_p0(P, lds, gw, NGW, wave, lane);
#endif
#ifdef PROBE_P02
    phase_p0(P, lds, gw, NGW, wave, lane);
#endif
    grid.sync();
    { pg8::Gemm g{XB, (const bf16*)(ws + WS_W1IN), TT, 2 * DFF, DM}; pg8::StaticOrder S; S.init(TT, 2 * DFF, G, (int)blockIdx.x);
      pg8::EpiSwiglu E{H, DFF}; pg8::gemm_phase<pg8::EpiSwiglu, pg8::StaticOrder, true, true>(lds, g, S, E); }
    grid.sync();
#ifdef PROBE_UP2
    { pg8::Gemm g{XB, (const bf16*)(ws + WS_W1IN), TT, 2 * DFF, DM}; pg8::StaticOrder S; S.init(TT, 2 * DFF, G, (int)blockIdx.x);
      pg8::EpiSwiglu E{H, DFF}; pg8::gemm_phase<pg8::EpiSwiglu, pg8::StaticOrder, true, true>(lds, g, S, E); }
    grid.sync();
#endif
#ifdef PROBE_SYNC10
    for (int q = 0; q < 10; ++q) grid.sync();
#endif
    { pg8::Gemm g{H, (const bf16*)(ws + WS_W1OUT), TT, DM, DFF}; pg8::StaticOrder S; S.init(TT, DM, G, (int)blockIdx.x);
      pg8::EpiResid E{P.in[0], P.in[1], SEQ0, out, ALPHA, 0.5f}; pg8::gemm_phase<pg8::EpiResid, pg8::StaticOrder, true, true>(lds, g, S, E); }
    grid.sync();
    phase_ln(out, XB, P.in[13], P.in[14], true, gw, NGW, lane);
    grid.sync();
    { pg8::Gemm g{XB, (const bf16*)(ws + WS_WIN), TT, NPROJ, DM}; pg8::StaticOrder S; S.init(TT, NPROJ, G, (int)blockIdx.x);
      pg8::EpiProj E{(bf16*)(ws + WS_AQKV), (bf16*)(ws + WS_DQKV), (bf16*)(ws + WS_Z), (float*)(ws + WS_BA)}; pg8::gemm_phase<pg8::EpiProj, pg8::StaticOrder, true, true>(lds, g, S, E); }
    grid.sync();
#ifndef SKIP_ATTN
    phase_attn((const bf16*)(ws + WS_AQKV), XB, P.in[6], lds, tid, wave, lane);
#endif
#ifdef PROBE_ATTN2
    phase_attn((const bf16*)(ws + WS_AQKV), XB, P.in[6], lds, tid, wave, lane);
#endif
#ifndef SKIP_CONV
    phase_conv((const bf16*)(ws + WS_DQKV), P.in[5], (bf16*)(ws + WS_QN), (bf16*)(ws + WS_KN), (bf16*)(ws + WS_V2), gw, NGW, lane);
#endif
#ifdef PROBE_CONV2
    phase_conv((const bf16*)(ws + WS_DQKV), P.in[5], (bf16*)(ws + WS_QN), (bf16*)(ws + WS_KN), (bf16*)(ws + WS_V2), gw, NGW, lane);
#endif
    grid.sync();
#ifndef SKIP_PREPB
    phase_prepb(P, lds, tid, wave, lane);
#endif
    grid.sync();
#ifndef SKIP_SCAN
    phase_scan(P, lds, tid, wave, lane);
#endif
#ifdef PROBE_SCAN2
    grid.sync();
    phase_scan(P, lds, tid, wave, lane);
#endif
    grid.sync();
#ifndef SKIP_GATE
    phase_gate(P, gw, NGW, lane);
#endif
    grid.sync();
    { pg8::Gemm g{XB, (const bf16*)(ws + WS_WOUT), TT, DM, DM}; pg8::StaticOrder S; S.init(TT, DM, G, (int)blockIdx.x);
      pg8::EpiResid E{out, out, TT, out, ALPHA, 1.0f}; pg8::gemm_phase<pg8::EpiResid, pg8::StaticOrder, true, true>(lds, g, S, E); }
    grid.sync();
    phase_ln(out, XB, P.in[13] + DM, P.in[14] + DM, true, gw, NGW, lane);
    grid.sync();
    { pg8::Gemm g{XB, (const bf16*)(ws + WS_W2IN), TT, 2 * DFF, DM}; pg8::StaticOrder S; S.init(TT, 2 * DFF, G, (int)blockIdx.x);
      pg8::EpiSwiglu E{H, DFF}; pg8::gemm_phase<pg8::EpiSwiglu, pg8::StaticOrder, true, true>(lds, g, S, E); }
    grid.sync();
    { pg8::Gemm g{H, (const bf16*)(ws + WS_W2OUT), TT, DM, DFF}; pg8::StaticOrder S; S.init(TT, DM, G, (int)blockIdx.x);
      pg8::EpiResid E{out, out, TT, out, ALPHA, 0.5f}; pg8::gemm_phase<pg8::EpiResid, pg8::StaticOrder, true, true>(lds, g, S, E); }
    grid.sync();
    phase_ln(out, XB, P.in[13] + 2 * DM, P.in[14] + 2 * DM, false, gw, NGW, lane);
}

extern "C" void kernel_launch(void* const* d_in, const int* in_sizes, int n_in, void* d_out, int out_size, void* d_ws, size_t ws_size, hipStream_t stream) {
    static int grid = 0;
    if (grid == 0) {
        if (n_in != 15 || out_size != TT * DM || ws_size < WS_END) { fprintf(stderr, "kernel_launch: unexpected shapes (n_in %d, out %d, ws %zu)\n", n_in, out_size, ws_size); grid = -1; return; }
        int dev = 0, cus = 0, per_cu = 0;
        hipGetDevice(&dev); hipDeviceGetAttribute(&cus, hipDeviceAttributeMultiprocessorCount, dev);
        if (hipFuncSetAttribute((const void*)fwd_megakernel, hipFuncAttributeMaxDynamicSharedMemorySize, LDS_BYTES) != hipSuccess) { fprintf(stderr, "kernel_launch: hipFuncSetAttribute failed\n"); grid = -1; return; }
        if (hipOccupancyMaxActiveBlocksPerMultiprocessor(&per_cu, (const void*)fwd_megakernel, NT, LDS_BYTES) != hipSuccess || per_cu < 1) { fprintf(stderr, "kernel_launch: occupancy query says %d\n", per_cu); per_cu = 1; }
        (void)hipGetLastError();
        grid = cus;
    }
    if (grid < 0) return;
    Params p{};
    for (int i = 0; i < 15; ++i) p.in[i] = (const float*)d_in[i];
    p.out = (float*)d_out; p.ws = (unsigned char*)d_ws;
    void* args[] = {&p};
    hipError_t e = hipLaunchCooperativeKernel((const void*)fwd_megakernel, dim3(grid), dim3(NT), args, LDS_BYTES, stream);
    if (e != hipSuccess) fprintf(stderr, "cooperative launch failed: %s (grid %d)\n", hipGetErrorString(e), grid);
}
```
